# Optimizing an MI355X kernel written in HIP

```python
import math
import jax, jax.numpy as jnp
from jax import lax
import numpy as np

D_MODEL = 2048
BATCH = 2
SEQ = 8192
DEPTH = 4

N_MIXERS = 3
N_MLA = (DEPTH + 2) // 3
N_RWKV = (DEPTH + 1) // 3
N_SWA = DEPTH // 3

DEEPNORM_ALPHA = (2.0 * DEPTH) ** 0.25
DEEPNORM_BETA = (8.0 * DEPTH) ** -0.25
LN_EPS = 1e-5
RMS_EPS = 1e-6
NEG_INF = -1e30
Q_BLOCK = 128

MLA_HEADS = 16
MLA_Q_RANK = 512
MLA_KV_RANK = 512
MLA_NOPE = 128
MLA_ROPE = 64
MLA_V = 128
ROPE_THETA = 10000.0

RWKV_HEAD = 64
RWKV_HEADS = D_MODEL // RWKV_HEAD
RWKV_DECAY_LORA = 96
RWKV_AAA_LORA = 96
RWKV_GATE_LORA = 256
RWKV_GN_EPS = 64e-5

SWA_HEAD = 64
SWA_Q_HEADS = D_MODEL // SWA_HEAD
SWA_KV_HEADS = 4
SWA_GROUP = SWA_Q_HEADS // SWA_KV_HEADS
WINDOW = 128
REL_BUCKETS = 32
REL_MAX_DIST = WINDOW

MLP_HIDDEN = 4 * D_MODEL

kernel_name = "hybrid_mla_rwkv7_swa_deepnorm"


def layer_norm(x, g, b):
    xf = x.astype(jnp.float32)
    mu = jnp.mean(xf, -1, keepdims=True)
    var = jnp.mean(jnp.square(xf - mu), -1, keepdims=True)
    return ((xf - mu) * lax.rsqrt(var + LN_EPS) * g + b).astype(x.dtype)


def rms_norm(x, g):
    xf = x.astype(jnp.float32)
    return (xf * lax.rsqrt(jnp.mean(jnp.square(xf), -1, keepdims=True) + RMS_EPS) * g).astype(x.dtype)


def rope(x, pos):
    half = x.shape[-1] // 2
    inv = ROPE_THETA ** (-jnp.arange(half, dtype=jnp.float32) / half)
    ang = pos.astype(jnp.float32)[:, None] * inv[None, :]
    cos = jnp.cos(ang)[:, None, :]
    sin = jnp.sin(ang)[:, None, :]
    x1 = x[..., :half].astype(jnp.float32)
    x2 = x[..., half:].astype(jnp.float32)
    return jnp.concatenate([x1 * cos - x2 * sin, x2 * cos + x1 * sin], -1).astype(x.dtype)


def causal_block_attention(q, k, v, scale):
    B, S, H, Dq = q.shape
    nb = S // Q_BLOCK
    q_blocks = q.reshape(B, nb, Q_BLOCK, H, Dq).swapaxes(0, 1)
    k_pos = jnp.arange(S)

    def one_block(args):
        qb, start = args
        s = jnp.einsum('bqhd,bkhd->bhqk', qb, k).astype(jnp.float32) * scale
        q_pos = start + jnp.arange(Q_BLOCK)
        s = jnp.where(k_pos[None, :] <= q_pos[:, None], s, NEG_INF)
        p = jax.nn.softmax(s, axis=-1).astype(v.dtype)
        return jnp.einsum('bhqk,bkhd->bqhd', p, v)

    o = lax.map(one_block, (q_blocks, jnp.arange(nb) * Q_BLOCK))
    return o.swapaxes(0, 1).reshape(B, S, H, v.shape[-1])


def mla_mixer(x, w_in, q_norm, kv_norm, w_q_b, w_kv_b, w_out):
    B, S, _ = x.shape
    h = x @ w_in
    q_lat, kv_lat, k_rope = jnp.split(h, [MLA_Q_RANK, MLA_Q_RANK + MLA_KV_RANK], axis=-1)
    q = (rms_norm(q_lat, q_norm) @ w_q_b).reshape(B, S, MLA_HEADS, MLA_NOPE + MLA_ROPE)
    kv = (rms_norm(kv_lat, kv_norm) @ w_kv_b).reshape(B, S, MLA_HEADS, MLA_NOPE + MLA_V)
    pos = jnp.arange(S)
    q = jnp.concatenate([q[..., :MLA_NOPE], rope(q[..., MLA_NOPE:], pos)], -1)
    k_rope = rope(k_rope[:, :, None, :], pos)
    k = jnp.concatenate([kv[..., :MLA_NOPE],
                         jnp.broadcast_to(k_rope, (B, S, MLA_HEADS, MLA_ROPE))], -1)
    v = kv[..., MLA_NOPE:]
    o = causal_block_attention(q, k, v, (MLA_NOPE + MLA_ROPE) ** -0.5)
    return o.reshape(B, S, MLA_HEADS * MLA_V) @ w_out


def wkv7_scan(r, w, k, v, a, b):
    B, S, H, N = r.shape
    seq_first = lambda t: jnp.moveaxis(t.astype(jnp.float32), 1, 0)

    def step(state, inp):
        rt, wt, kt, vt, at, bt = inp
        sa = jnp.einsum('bhvk,bhk->bhv', state, at)
        state = (state * wt[:, :, None, :] + sa[..., None] * bt[:, :, None, :]
                 + vt[..., None] * kt[:, :, None, :])
        return state, jnp.einsum('bhvk,bhk->bhv', state, rt)

    state0 = jnp.zeros((B, H, N, N), jnp.float32)
    _, y = lax.scan(step, state0, tuple(seq_first(t) for t in (r, w, k, v, a, b)))
    return jnp.moveaxis(y, 0, 1)


def rwkv7_mixer(x, mix, w_in, w0, w1, w2, a0, a1, a2, g1, g2, k_k, k_a, r_k, ln_g, ln_b, w_out):
    B, S, D = x.shape
    H, N = RWKV_HEADS, RWKV_HEAD
    heads = lambda t: t.reshape(B, S, H, N)
    xx = jnp.pad(x, ((0, 0), (1, 0), (0, 0)))[:, :-1] - x
    x_rkv = x[None] + xx[None] * mix[jnp.array([0, 2, 3])][:, None, None, :]
    xw = x + xx * mix[1]
    xa = x + xx * mix[4]
    xg = x + xx * mix[5]
    r, k, v = jnp.einsum('nbsd,nde->nbse', x_rkv, w_in)
    log_w = -jax.nn.softplus(-(w0 + jnp.tanh(xw @ w1) @ w2)) - 0.5
    decay = jnp.exp(-jnp.exp(log_w.astype(jnp.float32)))
    a = jax.nn.sigmoid(a0 + (xa @ a1) @ a2)
    g = jax.nn.sigmoid(xg @ g1) @ g2
    kk = heads(k * k_k).astype(jnp.float32)
    kk = kk / jnp.maximum(jnp.sqrt(jnp.sum(jnp.square(kk), -1, keepdims=True)), 1e-12)
    k = k * (1.0 + (a - 1.0) * k_a)
    y = wkv7_scan(heads(r), heads(decay), heads(k), heads(v), -kk, kk * heads(a).astype(jnp.float32))
    mu = jnp.mean(y, -1, keepdims=True)
    var = jnp.mean(jnp.square(y - mu), -1, keepdims=True)
    y = ((y - mu) * lax.rsqrt(var + RWKV_GN_EPS)).reshape(B, S, D) * ln_g + ln_b
    bonus = jnp.sum(heads(r) * heads(k) * r_k, -1, keepdims=True) * heads(v)
    y = y + bonus.reshape(B, S, D)
    return (y * g).astype(x.dtype) @ w_out


def t5_bucket(dist):
    max_exact = REL_BUCKETS // 2
    n = jnp.maximum(dist, 0)
    nf = jnp.maximum(n, 1).astype(jnp.float32)
    large = max_exact + (jnp.log(nf / max_exact) / math.log(REL_MAX_DIST / max_exact)
                         * (REL_BUCKETS - max_exact)).astype(jnp.int32)
    large = jnp.minimum(large, REL_BUCKETS - 1)
    return jnp.where(n < max_exact, n, large)


def swa_mixer(x, w_in, b_in, sinks, w_out, b_out, rel_bias):
    B, S, _ = x.shape
    Hq, Hk, G, Dh, W = SWA_Q_HEADS, SWA_KV_HEADS, SWA_GROUP, SWA_HEAD, WINDOW
    nb = S // W
    qkv = x @ w_in + b_in
    q, k, v = jnp.split(qkv, [Hq * Dh, (Hq + Hk) * Dh], axis=-1)
    q = q.reshape(B, nb, W, Hk, G, Dh)
    k = k.reshape(B, nb, W, Hk, Dh)
    v = v.reshape(B, nb, W, Hk, Dh)
    band = lambda t: jnp.concatenate(
        [jnp.pad(t, ((0, 0), (1, 0), (0, 0), (0, 0), (0, 0)))[:, :-1], t], axis=2)
    k_band, v_band = band(k), band(v)
    dist = jnp.arange(W)[:, None] + W - jnp.arange(2 * W)[None, :]
    in_window = (dist >= 0) & (dist < W)
    bias = rel_bias[t5_bucket(dist)].astype(jnp.float32)
    bias = jnp.where(in_window[..., None], bias, NEG_INF)
    bias = bias.transpose(2, 0, 1).reshape(Hk, G, W, 2 * W)
    sink = sinks.astype(jnp.float32).reshape(Hk, G, 1, 1)
    scale = Dh ** -0.5

    def one_block(args):
        qb, kb, vb, blk = args
        s = jnp.einsum('bqhgd,bshd->bhgqs', qb, kb).astype(jnp.float32) * scale + bias
        key_ok = blk * W + jnp.arange(2 * W) - W >= 0
        s = jnp.where(key_ok, s, NEG_INF)
        s = jnp.concatenate([s, jnp.broadcast_to(sink, s.shape[:-1] + (1,))], -1)
        p = jax.nn.softmax(s, axis=-1)[..., :-1].astype(vb.dtype)
        return jnp.einsum('bhgqs,bshd->bqhgd', p, vb)

    o = lax.map(one_block, (q.swapaxes(0, 1), k_band.swapaxes(0, 1), v_band.swapaxes(0, 1), jnp.arange(nb)))
    o = o.swapaxes(0, 1).reshape(B, S, Hq * Dh)
    return o @ w_out + b_out


def setup_inputs(seed: int = 0) -> dict:
    keys = iter(jax.random.split(jax.random.key(seed), 48))
    nrm = lambda shape, scale: jax.random.normal(next(keys), shape, jnp.float32) * scale
    D = D_MODEL
    mla_in = MLA_Q_RANK + MLA_KV_RANK + MLA_ROPE
    swa_in = (SWA_Q_HEADS + 2 * SWA_KV_HEADS) * SWA_HEAD
    return {
        "x": nrm((BATCH, SEQ, D), 1.0),
        "mla_w_in": nrm((N_MLA, D, mla_in), D ** -0.5),
        "mla_q_norm": 1.0 + nrm((N_MLA, MLA_Q_RANK), 0.02),
        "mla_kv_norm": 1.0 + nrm((N_MLA, MLA_KV_RANK), 0.02),
        "mla_w_q_b": nrm((N_MLA, MLA_Q_RANK, MLA_HEADS * (MLA_NOPE + MLA_ROPE)), MLA_Q_RANK ** -0.5),
        "mla_w_kv_b": nrm((N_MLA, MLA_KV_RANK, MLA_HEADS * (MLA_NOPE + MLA_V)), MLA_KV_RANK ** -0.5),
        "mla_w_out": nrm((N_MLA, MLA_HEADS * MLA_V, D), DEEPNORM_BETA * (MLA_HEADS * MLA_V) ** -0.5),
        "rwkv_mix": jax.random.uniform(next(keys), (N_RWKV, 6, D), jnp.float32),
        "rwkv_w_in": nrm((N_RWKV, 3, D, D), D ** -0.5),
        "rwkv_w0": jax.random.uniform(next(keys), (N_RWKV, D), jnp.float32, -6.0, -1.0),
        "rwkv_w1": nrm((N_RWKV, D, RWKV_DECAY_LORA), D ** -0.5),
        "rwkv_w2": nrm((N_RWKV, RWKV_DECAY_LORA, D), 0.5 * RWKV_DECAY_LORA ** -0.5),
        "rwkv_a0": nrm((N_RWKV, D), 0.02),
        "rwkv_a1": nrm((N_RWKV, D, RWKV_AAA_LORA), D ** -0.5),
        "rwkv_a2": nrm((N_RWKV, RWKV_AAA_LORA, D), 0.1 * RWKV_AAA_LORA ** -0.5),
        "rwkv_g1": nrm((N_RWKV, D, RWKV_GATE_LORA), D ** -0.5),
        "rwkv_g2": nrm((N_RWKV, RWKV_GATE_LORA, D), RWKV_GATE_LORA ** -0.5),
        "rwkv_k_k": 0.85 + nrm((N_RWKV, D), 0.02),
        "rwkv_k_a": 1.0 + nrm((N_RWKV, D), 0.02),
        "rwkv_r_k": nrm((N_RWKV, RWKV_HEADS, RWKV_HEAD), 0.1),
        "rwkv_ln_g": 1.0 + nrm((N_RWKV, D), 0.02),
        "rwkv_ln_b": nrm((N_RWKV, D), 0.02),
        "rwkv_w_out": nrm((N_RWKV, D, D), DEEPNORM_BETA * D ** -0.5),
        "swa_w_in": nrm((N_SWA, D, swa_in), D ** -0.5),
        "swa_b_in": nrm((N_SWA, swa_in), 0.02),
        "swa_sinks": nrm((N_SWA, SWA_Q_HEADS), 1.0),
        "swa_w_out": nrm((N_SWA, SWA_Q_HEADS * SWA_HEAD, D), DEEPNORM_BETA * (SWA_Q_HEADS * SWA_HEAD) ** -0.5),
        "swa_b_out": nrm((N_SWA, D), 0.02),
        "rel_bias": nrm((REL_BUCKETS, SWA_Q_HEADS), 0.5),
        "ln_g": 1.0 + nrm((DEPTH, 2, D), 0.02),
        "ln_b": nrm((DEPTH, 2, D), 0.02),
        "mlp_up": nrm((DEPTH, D, MLP_HIDDEN), D ** -0.5),
        "mlp_down": nrm((DEPTH, MLP_HIDDEN, D), DEEPNORM_BETA * MLP_HIDDEN ** -0.5),
    }


def reference(x, mla_w_in, mla_q_norm, mla_kv_norm, mla_w_q_b, mla_w_kv_b, mla_w_out,
              rwkv_mix, rwkv_w_in, rwkv_w0, rwkv_w1, rwkv_w2, rwkv_a0, rwkv_a1, rwkv_a2,
              rwkv_g1, rwkv_g2, rwkv_k_k, rwkv_k_a, rwkv_r_k, rwkv_ln_g, rwkv_ln_b, rwkv_w_out,
              swa_w_in, swa_b_in, swa_sinks, swa_w_out, swa_b_out,
              rel_bias, ln_g, ln_b, mlp_up, mlp_down):
    h = x
    for i in range(DEPTH):
        j = i // N_MIXERS
        kind = i % N_MIXERS
        if kind == 0:
            mixed = mla_mixer(h, mla_w_in[j], mla_q_norm[j], mla_kv_norm[j],
                              mla_w_q_b[j], mla_w_kv_b[j], mla_w_out[j])
        elif kind == 1:
            mixed = rwkv7_mixer(h, rwkv_mix[j], rwkv_w_in[j], rwkv_w0[j], rwkv_w1[j], rwkv_w2[j],
                                rwkv_a0[j], rwkv_a1[j], rwkv_a2[j], rwkv_g1[j], rwkv_g2[j],
                                rwkv_k_k[j], rwkv_k_a[j], rwkv_r_k[j], rwkv_ln_g[j], rwkv_ln_b[j],
                                rwkv_w_out[j])
        else:
            mixed = swa_mixer(h, swa_w_in[j], swa_b_in[j], swa_sinks[j], swa_w_out[j],
                              swa_b_out[j], rel_bias)
        h = layer_norm(DEEPNORM_ALPHA * h + mixed, ln_g[i, 0], ln_b[i, 0])
        ff = jnp.square(jax.nn.relu(h @ mlp_up[i])) @ mlp_down[i]
        h = layer_norm(DEEPNORM_ALPHA * h + ff, ln_g[i, 1], ln_b[i, 1])
    return h
```

```cpp
#include <hip/hip_runtime.h>
#include <hip/hip_cooperative_groups.h>
#include <cstdio>
#include <cstdint>
namespace cg = cooperative_groups;

#define GAS __attribute__((address_space(1)))
#define LAS __attribute__((address_space(3)))
typedef unsigned short bf16_t;
typedef short bf16x8 __attribute__((ext_vector_type(8)));
typedef float f32x4 __attribute__((ext_vector_type(4)));
typedef float f32x2 __attribute__((ext_vector_type(2)));
typedef float f32x16 __attribute__((ext_vector_type(16)));
typedef unsigned u32x4 __attribute__((ext_vector_type(4)));
typedef unsigned u32x2 __attribute__((ext_vector_type(2)));

constexpr int M = 16384, DM = 2048, SEQ = 8192, FF = 8192;
constexpr float ALPHA = 1.6817928305074290f;
constexpr float LOG2E = 1.4426950408889634f;
constexpr size_t MiB = 1u << 20;
constexpr size_t WS_TAB = 0;
constexpr size_t WS_BT = 2 * MiB;
constexpr size_t WS_STATS = 3 * MiB;
constexpr size_t WS_BAR = 3 * MiB + 512 * 1024;
constexpr size_t WS_BAR_BYTES = 16384;
constexpr size_t WS_MLA_W = 4 * MiB;
constexpr size_t WS_RW_W = 44 * MiB;
constexpr size_t WS_SW_W = 82 * MiB;
constexpr size_t WS_MLPW = 100 * MiB;
constexpr size_t WS_HB = 164 * MiB;
constexpr size_t WS_Y = 228 * MiB;
constexpr size_t WS_AR = 356 * MiB;
constexpr size_t WS_END = WS_AR + 602 * MiB;
constexpr size_t AR_HID = 0;
constexpr size_t AR_LAT = 0, AR_PART = 32 * MiB, AR_KROPE = 33 * MiB, AR_Q = 36 * MiB, AR_KN = 132 * MiB, AR_VT = 196 * MiB, AR_O = 260 * MiB;
constexpr size_t AR_BON = 600 * MiB;
constexpr size_t AR_X6 = 0, AR_RKV = 384 * MiB, AR_LH = 576 * MiB, AR_DEC = 0, AR_AF = 128 * MiB, AR_GB = 256 * MiB, AR_YG = 320 * MiB;
constexpr size_t AR_SQ = 0, AR_SK = 64 * MiB, AR_SVT = 72 * MiB, AR_SO = 80 * MiB;
constexpr size_t SLOT = (size_t)M * DM * 2;

constexpr int LDS_BYTES = 131072 + 4096;

__device__ __forceinline__ unsigned cvt_pk_bf16(float lo, float hi) { unsigned r; asm volatile("v_cvt_pk_bf16_f32 %0, %1, %2" : "=v"(r) : "v"(lo), "v"(hi)); return r; }
__device__ __forceinline__ float bf2f(unsigned short b) { return __builtin_bit_cast(float, (unsigned)b << 16); }
__device__ __forceinline__ float bflo(unsigned w) { return __builtin_bit_cast(float, w << 16); }
__device__ __forceinline__ float bfhi(unsigned w) { return __builtin_bit_cast(float, w & 0xffff0000u); }
__device__ __forceinline__ u32x4 pack8(f32x4 a, f32x4 b) { u32x4 w; w.x = cvt_pk_bf16(a[0], a[1]); w.y = cvt_pk_bf16(a[2], a[3]); w.z = cvt_pk_bf16(b[0], b[1]); w.w = cvt_pk_bf16(b[2], b[3]); return w; }
__device__ __forceinline__ float wave_sum(float v) {
#pragma unroll
    for (int o = 1; o < 64; o <<= 1) v += __shfl_xor(v, o);
    return v;
}
template <int CTRL> __device__ __forceinline__ float dpp_f(float x) { return __builtin_bit_cast(float, __builtin_amdgcn_update_dpp(0, __builtin_bit_cast(int, x), CTRL, 0xF, 0xF, true)); }
__device__ __forceinline__ float sum16(float x) { x += dpp_f<0xB1>(x); x += dpp_f<0x4E>(x); x += dpp_f<0x141>(x); x += dpp_f<0x140>(x); return x; }
__device__ __forceinline__ float sigmoidf_(float x) { return 1.0f / (1.0f + __expf(-x)); }
__device__ __forceinline__ int crow(int r, int hi) { return (r & 3) + 8 * (r >> 2) + 4 * hi; }

namespace pg8 {
constexpr int BM = 256, BK = 64, HALF = 128, HTB = HALF * BK * 2, STAGE_BYTES = 8 * HTB, NXCD = 8, WGM = 4;
__host__ __device__ __forceinline__ int lds_byte(int r, int c) { const int st = (r >> 4) * 2 + (c >> 5), rr = r & 15, cc = c & 31, ob = rr * 64 + cc * 2; return st * 1024 + (ob ^ (((ob >> 9) & 1) << 5)); }
__host__ __device__ __forceinline__ void stage_rc(int b, int& R, int& C) { const int st = b / 1024, sb = b % 1024, swz = sb ^ (((sb >> 9) & 1) << 5); R = (st >> 1) * 16 + swz / 64; C = (st & 1) * 32 + (swz % 64) / 2; }
__host__ __device__ __forceinline__ int perm32(int rho) { const int n = rho >> 4, i = rho & 15; return 8 * (i >> 2) + 4 * n + (i & 3); }

struct Unit { int pm, pn; };
struct Gemm { const bf16_t* A; const bf16_t* Bt; int M, N, K, lda, ldb, a_group; size_t a_stride; };

struct StaticOrder {
    int nM, nN, nwg, G, c;
    __device__ void init(int M_, int N_, int G_, int c_) { nM = M_ / BM; nN = N_ / BM; nwg = nM * nN; G = G_; c = c_; }
    __device__ bool next(int i, Unit& u) const {
        const long L = (long)i * G + c; if (L >= nwg) return false;
        int wgid = (int)L; { const int q = nwg / NXCD, r = nwg % NXCD, xcd = wgid % NXCD, off = wgid / NXCD; wgid = (xcd < r ? xcd * (q + 1) : r * (q + 1) + (xcd - r) * q) + off; }
        const int nig = WGM * nN, gid = wgid / nig, fm = gid * WGM, gsz = (nM - fm) < WGM ? (nM - fm) : WGM;
        u.pm = fm + ((wgid % nig) % gsz); u.pn = (wgid % nig) / gsz; return true;
    }
};

template <class Epi>
__device__ __forceinline__ void gemm_phase(LAS unsigned char* lds, const Gemm g, const StaticOrder& S, const Epi& E, const int tid) {
    const int wid = __builtin_amdgcn_readfirstlane(tid >> 6), lane = tid & 63, wr = wid >> 2, wc = wid & 3, fr = lane & 15, fq = lane >> 4;
    const int K = g.K, nt = K / BK;
    unsigned voffA[2], voffB[2];
#pragma unroll
    for (int i = 0; i < 2; ++i) { int R, C; stage_rc(tid * 16 + i * 8192, R, C); const int Rb = (R & ~31) + perm32(R & 31);
        voffA[i] = (unsigned)(R * g.lda + C) * 2u; voffB[i] = (unsigned)(Rb * g.ldb + C) * 2u; }
    const size_t kstep = (size_t)(BK * 2);
    const size_t hstepA = (size_t)HALF * g.lda * 2, hstepB = (size_t)HALF * g.ldb * 2;
    const size_t tstepA = 2 * hstepA, tstepB = 2 * hstepB;
    const unsigned ldsw = (unsigned)wid * 1024u;
    const int aoff = lds_byte(wr * 64 + fr, fq * 8), boff = lds_byte(wc * 32 + fr, fq * 8);
#define PG8_SA(b, h) (((b) * 2 + (h)) * HTB)
#define PG8_SB(b, h) ((4 + (b) * 2 + (h)) * HTB)
#define PG8_STAGE(bufoff, gbase, voff) do { _Pragma("unroll") for (int _i = 0; _i < 2; ++_i) \
        __builtin_amdgcn_global_load_lds((const unsigned*)((const char*)(gbase) + (voff)[_i]), (LAS unsigned*)(lds + (bufoff) + ldsw + _i * 8192), 16, 0, 0); } while (0)
#define PG8_LDA(dst, b, h) do { _Pragma("unroll") for (int m = 0; m < 4; ++m) _Pragma("unroll") for (int k = 0; k < 2; ++k) dst[m][k] = *(const LAS bf16x8*)(lds + PG8_SA(b, h) + aoff + m * 2048 + k * 1024); } while (0)
#define PG8_LDB(dst, b, h) do { _Pragma("unroll") for (int n = 0; n < 2; ++n) _Pragma("unroll") for (int k = 0; k < 2; ++k) dst[n][k] = *(const LAS bf16x8*)(lds + PG8_SB(b, h) + boff + n * 2048 + k * 1024); } while (0)
#define PG8_MMA(ai, bj, At, Bt) do { __builtin_amdgcn_s_setprio(1); _Pragma("unroll") for (int m = 0; m < 4; ++m) _Pragma("unroll") for (int n = 0; n < 2; ++n) _Pragma("unroll") for (int k = 0; k < 2; ++k) \
        acc[ai][bj][m][n] = __builtin_amdgcn_mfma_f32_16x16x32_bf16(Bt[n][k], At[m][k], acc[ai][bj][m][n], 0, 0, 0); __builtin_amdgcn_s_setprio(0); } while (0)
#define PG8_WAIT_V(n) asm volatile("s_waitcnt vmcnt(" #n ")" ::: "memory")
#define PG8_WAIT_L(n) asm volatile("s_waitcnt lgkmcnt(" #n ")" ::: "memory")
#define PG8_BAR __builtin_amdgcn_s_barrier()
#define PG8_SCHED __builtin_amdgcn_sched_barrier(0)
    Unit cur, nxt; int ui = 0;
    if (!S.next(0, cur)) return;
    f32x4 acc[2][2][4][2];
#pragma unroll
    for (int a = 0; a < 2; ++a)
#pragma unroll
        for (int b = 0; b < 2; ++b)
#pragma unroll
            for (int m = 0; m < 4; ++m)
#pragma unroll
                for (int n = 0; n < 2; ++n) acc[a][b][m][n] = (f32x4){0.f, 0.f, 0.f, 0.f};
    bf16x8 At[4][2], B0[2][2], B1[2][2];
    const char* cA = (const char*)g.A + (size_t)cur.pm * tstepA + (size_t)(cur.pn / g.a_group) * g.a_stride; const char* cB = (const char*)g.Bt + (size_t)cur.pn * tstepB;
    PG8_STAGE(PG8_SB(0, 0), cB, voffB); PG8_STAGE(PG8_SB(0, 1), cB + hstepB, voffB); PG8_STAGE(PG8_SA(0, 0), cA, voffA); PG8_STAGE(PG8_SA(0, 1), cA + hstepA, voffA);
    if (wr == 1) PG8_BAR;
    PG8_WAIT_V(2); PG8_BAR;
    PG8_STAGE(PG8_SB(1, 0), cB + kstep, voffB); PG8_STAGE(PG8_SA(1, 0), cA + kstep, voffA); PG8_STAGE(PG8_SB(1, 1), cB + hstepB + kstep, voffB);
    PG8_WAIT_V(6); PG8_BAR;
    for (;;) {
        const bool has_next = S.next(ui + 1, nxt);
        const char* nA = has_next ? (const char*)g.A + (size_t)nxt.pm * tstepA + (size_t)(nxt.pn / g.a_group) * g.a_stride : cA; const char* nB = has_next ? (const char*)g.Bt + (size_t)nxt.pn * tstepB : cB;
        for (int t = 0; t < nt; t += 2) {
            const bool last = (t == nt - 2);
            const char* a1 = cA + (size_t)(t + 1) * kstep;
            const char* a2 = last ? nA : cA + (size_t)(t + 2) * kstep; const char* b2 = last ? nB : cB + (size_t)(t + 2) * kstep;
            const char* a3 = a2 + kstep; const char* b3 = b2 + kstep;
            PG8_LDB(B0, 0, 0); PG8_LDB(B1, 0, 1); PG8_SCHED; PG8_LDA(At, 0, 0); PG8_STAGE(PG8_SA(1, 1), a1 + hstepA, voffA);
            PG8_WAIT_V(8); PG8_WAIT_L(0); PG8_BAR; PG8_MMA(0, 0, At, B0); PG8_MMA(0, 1, At, B1); PG8_BAR; PG8_SCHED;
            PG8_LDA(At, 0, 1); PG8_STAGE(PG8_SB(0, 0), b2, voffB); PG8_STAGE(PG8_SB(0, 1), b2 + hstepB, voffB); PG8_STAGE(PG8_SA(0, 0), a2, voffA);
            PG8_WAIT_V(8); PG8_WAIT_L(0); PG8_BAR; PG8_MMA(1, 0, At, B0); PG8_MMA(1, 1, At, B1); PG8_BAR; PG8_SCHED;
            PG8_LDB(B0, 1, 0); PG8_LDB(B1, 1, 1); PG8_SCHED; PG8_LDA(At, 1, 0); PG8_STAGE(PG8_SA(0, 1), a2 + hstepA, voffA);
            PG8_WAIT_V(8); PG8_WAIT_L(0); PG8_BAR; PG8_MMA(0, 0, At, B0); PG8_MMA(0, 1, At, B1); PG8_BAR; PG8_SCHED;
            PG8_LDA(At, 1, 1); PG8_STAGE(PG8_SB(1, 0), b3, voffB); PG8_STAGE(PG8_SB(1, 1), b3 + hstepB, voffB); PG8_STAGE(PG8_SA(1, 0), a3, voffA);
            PG8_WAIT_V(8); PG8_WAIT_L(0); PG8_BAR; PG8_MMA(1, 0, At, B0); PG8_MMA(1, 1, At, B1); PG8_BAR; PG8_SCHED;
        }
        if (wr == 0) PG8_BAR;
        E(acc, cur, wr, wc, fr, fq);
        if (!has_next) break;
#pragma unroll
        for (int a = 0; a < 2; ++a)
#pragma unroll
            for (int b = 0; b < 2; ++b)
#pragma unroll
                for (int m = 0; m < 4; ++m)
#pragma unroll
                    for (int n = 0; n < 2; ++n) acc[a][b][m][n] = (f32x4){0.f, 0.f, 0.f, 0.f};
        cur = nxt; cA = nA; cB = nB; ++ui;
        if (wr == 1) PG8_BAR;
    }
    PG8_WAIT_V(0);
    PG8_BAR;
#undef PG8_SA
#undef PG8_SB
#undef PG8_STAGE
#undef PG8_LDA
#undef PG8_LDB
#undef PG8_MMA
#undef PG8_WAIT_V
#undef PG8_WAIT_L
#undef PG8_BAR
#undef PG8_SCHED
}
}

enum EpiMode { EM_RESID = 0, EM_RELU2, EM_SPLIT, EM_LORA_DOWN, EM_LORA_UP, EM_SWA_QKV, EM_MLA_IN, EM_MLA_Q, EM_MLA_KV };
struct EpiP {
    int mode;
    const float* res; const float* bias; float* outf;
    bf16_t* o0; bf16_t* o1; bf16_t* o2;
    float* f0; float* f1;
    const float* p0; const float* p1;
    const float* tab;
    int ldc;
    __device__ __forceinline__ void operator()(const f32x4 (&acc)[2][2][4][2], const pg8::Unit& u, int wr, int wc, int fr, int fq) const {
        const int row0 = u.pm * 256 + wr * 64 + fr, colb = u.pn * 256 + wc * 32 + 8 * fq;
#define EPI_BEGIN _Pragma("unroll") for (int ai = 0; ai < 2; ++ai) _Pragma("unroll") for (int m = 0; m < 4; ++m) { const int row = row0 + ai * 128 + m * 16; \
        _Pragma("unroll") for (int bj = 0; bj < 2; ++bj) { const int col = colb + bj * 128; f32x4 v0 = acc[ai][bj][m][0], v1 = acc[ai][bj][m][1];
#define EPI_END } asm volatile("" ::: "memory"); }
        if (mode == EM_RESID) {
            EPI_BEGIN { const size_t off = (size_t)row * ldc + col; f32x4 r0 = *(const f32x4*)(res + off), r1 = *(const f32x4*)(res + off + 4);
                if (p0) { const f32x2 ms = *(const f32x2*)(f0 + 2 * (size_t)row); const f32x4 g0 = *(const f32x4*)(p0 + col), g1 = *(const f32x4*)(p0 + col + 4), b0 = *(const f32x4*)(p1 + col), b1 = *(const f32x4*)(p1 + col + 4);
                    r0 = (r0 - ms[0]) * ms[1] * g0 + b0; r1 = (r1 - ms[0]) * ms[1] * g1 + b1; }
                if (bias) { v0 += *(const f32x4*)(bias + col); v1 += *(const f32x4*)(bias + col + 4); }
                *(f32x4*)(outf + off) = r0 * ALPHA + v0; *(f32x4*)(outf + off + 4) = r1 * ALPHA + v1; } EPI_END
        } else if (mode == EM_RELU2) {
            EPI_BEGIN { const f32x4 z = {0.f, 0.f, 0.f, 0.f}; v0 = __builtin_elementwise_max(v0, z); v1 = __builtin_elementwise_max(v1, z); v0 = v0 * v0; v1 = v1 * v1;
                *(u32x4*)(o0 + (size_t)row * ldc + col) = pack8(v0, v1); } EPI_END
        } else if (mode == EM_SPLIT) {
            EPI_BEGIN { const int s = col >> 11, c = col & 2047; *(u32x4*)(o0 + (size_t)s * (SLOT / 2) + (size_t)row * 2048 + c) = pack8(v0, v1); } EPI_END
        } else if (mode == EM_LORA_DOWN) {
            const int pn = u.pn;
            EPI_BEGIN {
                if (pn == 0) {
#pragma unroll
                    for (int e = 0; e < 4; ++e) { v0[e] = 1.0f - 2.0f / (1.0f + __expf(2.0f * v0[e])); v1[e] = 1.0f - 2.0f / (1.0f + __expf(2.0f * v1[e])); }
                } else if (pn == 2) {
#pragma unroll
                    for (int e = 0; e < 4; ++e) { v0[e] = sigmoidf_(v0[e]); v1[e] = sigmoidf_(v1[e]); }
                }
                *(u32x4*)(o0 + (size_t)row * 768 + col) = pack8(v0, v1); } EPI_END
        } else if (mode == EM_LORA_UP) {
            const int grp = u.pn >> 3;
            EPI_BEGIN { const int c = col & 2047; const size_t off = (size_t)row * 2048 + c;
                if (grp == 0) { const f32x4 b0 = *(const f32x4*)(p0 + c), b1 = *(const f32x4*)(p0 + c + 4);
#pragma unroll
                    for (int e = 0; e < 4; ++e) { v0[e] = __expf(-0.6065306597126334f * sigmoidf_(v0[e] + b0[e])); v1[e] = __expf(-0.6065306597126334f * sigmoidf_(v1[e] + b1[e])); }
                    *(f32x4*)(f0 + off) = v0; *(f32x4*)(f0 + off + 4) = v1;
                } else if (grp == 1) { const f32x4 b0 = *(const f32x4*)(p1 + c), b1 = *(const f32x4*)(p1 + c + 4);
#pragma unroll
                    for (int e = 0; e < 4; ++e) { v0[e] = sigmoidf_(v0[e] + b0[e]); v1[e] = sigmoidf_(v1[e] + b1[e]); }
                    *(f32x4*)(f1 + off) = v0; *(f32x4*)(f1 + off + 4) = v1;
                } else { *(u32x4*)(o0 + off) = pack8(v0, v1); } } EPI_END
        } else if (mode == EM_SWA_QKV) {
            const float qs = 0.125f * LOG2E;
            EPI_BEGIN { v0 += *(const f32x4*)(bias + col); v1 += *(const f32x4*)(bias + col + 4);
                if (col < 2048) { *(u32x4*)(o0 + (size_t)row * 2048 + col) = pack8(v0 * qs, v1 * qs); }
                else if (col < 2304) { *(u32x4*)(o1 + (size_t)row * 256 + (col - 2048)) = pack8(v0, v1); }
                else { const int d = col - 2304, b = row >> 13, t = row & 8191; bf16_t* vp = o2 + ((size_t)(b * 256 + d)) * 8192 + t; const u32x4 w = pack8(v0, v1);
                    vp[0] = (bf16_t)(w.x & 0xffff); vp[8192] = (bf16_t)(w.x >> 16); vp[2 * 8192] = (bf16_t)(w.y & 0xffff); vp[3 * 8192] = (bf16_t)(w.y >> 16);
                    vp[4 * 8192] = (bf16_t)(w.z & 0xffff); vp[5 * 8192] = (bf16_t)(w.z >> 16); vp[6 * 8192] = (bf16_t)(w.w & 0xffff); vp[7 * 8192] = (bf16_t)(w.w >> 16); } } EPI_END
        } else if (mode == EM_MLA_IN) {
            const int pn = u.pn;
#pragma unroll
            for (int ai = 0; ai < 2; ++ai)
#pragma unroll
                for (int m = 0; m < 4; ++m) { const int row = row0 + ai * 128 + m * 16;
                    if (pn < 4) { float ss = 0.f;
#pragma unroll
                        for (int bj = 0; bj < 2; ++bj) { const int col = colb + bj * 128; const f32x4 v0 = acc[ai][bj][m][0], v1 = acc[ai][bj][m][1];
                            ss += (v0[0] * v0[0] + v0[1] * v0[1]) + (v0[2] * v0[2] + v0[3] * v0[3]) + (v1[0] * v1[0] + v1[1] * v1[1]) + (v1[2] * v1[2] + v1[3] * v1[3]);
                            *(u32x4*)(o0 + (size_t)row * 1024 + col) = pack8(v0, v1); }
                        ss += __shfl_xor(ss, 16); ss += __shfl_xor(ss, 32);
                        if (fq == 0) f0[(size_t)row * 16 + pn * 4 + wc] = ss;
                    } else if (wc < 2) {
                        const f32x4 v0 = acc[ai][0][m][0], v1 = acc[ai][0][m][1]; const int pos = row & 8191, i0 = 16 * wc + 4 * fq;
                        const f32x4 t0 = *(const f32x4*)(tab + ((size_t)pos * 32 + i0) * 2), t1 = *(const f32x4*)(tab + ((size_t)pos * 32 + i0) * 2 + 4);
                        const float a0 = v0[0] * t0[0] - v0[1] * t0[1], b0 = v0[1] * t0[0] + v0[0] * t0[1];
                        const float a1 = v0[2] * t0[2] - v0[3] * t0[3], b1 = v0[3] * t0[2] + v0[2] * t0[3];
                        const float a2 = v1[0] * t1[0] - v1[1] * t1[1], b2 = v1[1] * t1[0] + v1[0] * t1[1];
                        const float a3 = v1[2] * t1[2] - v1[3] * t1[3], b3 = v1[3] * t1[2] + v1[2] * t1[3];
                        u32x2 wa, wb; wa.x = cvt_pk_bf16(a0, a1); wa.y = cvt_pk_bf16(a2, a3); wb.x = cvt_pk_bf16(b0, b1); wb.y = cvt_pk_bf16(b2, b3);
                        *(u32x2*)(o1 + (size_t)row * 64 + i0) = wa; *(u32x2*)(o1 + (size_t)row * 64 + 32 + i0) = wb; }
                    asm volatile("" ::: "memory");
                }
        } else if (mode == EM_MLA_Q) {
            const int pn = u.pn; const float qsc = 0.07216878364870322f * LOG2E;
#pragma unroll
            for (int ai = 0; ai < 2; ++ai)
#pragma unroll
                for (int m = 0; m < 4; ++m) { const int row = row0 + ai * 128 + m * 16;
                    const f32x4 pa = *(const f32x4*)(f0 + (size_t)row * 16), pb = *(const f32x4*)(f0 + (size_t)row * 16 + 4);
                    const float ssq = ((pa[0] + pa[1]) + (pa[2] + pa[3])) + ((pb[0] + pb[1]) + (pb[2] + pb[3]));
                    const float sc = qsc / sqrtf(ssq * (1.0f / 512.0f) + 1e-6f);
#pragma unroll
                    for (int bj = 0; bj < 2; ++bj) { const int col = colb + bj * 128; const f32x4 v0 = acc[ai][bj][m][0] * sc, v1 = acc[ai][bj][m][1] * sc;
                        if (pn < 8) { const int h = col >> 7, d = col & 127; *(u32x4*)(o0 + (size_t)row * 3072 + h * 192 + d) = pack8(v0, v1); }
                        else { const int j = col - 2048, h = j >> 6, i0 = (j & 63) >> 1, pos = row & 8191;
                            const f32x4 t0 = *(const f32x4*)(tab + ((size_t)pos * 32 + i0) * 2), t1 = *(const f32x4*)(tab + ((size_t)pos * 32 + i0) * 2 + 4);
                            const float a0 = v0[0] * t0[0] - v0[1] * t0[1], b0 = v0[1] * t0[0] + v0[0] * t0[1];
                            const float a1 = v0[2] * t0[2] - v0[3] * t0[3], b1 = v0[3] * t0[2] + v0[2] * t0[3];
                            const float a2 = v1[0] * t1[0] - v1[1] * t1[1], b2 = v1[1] * t1[0] + v1[0] * t1[1];
                            const float a3 = v1[2] * t1[2] - v1[3] * t1[3], b3 = v1[3] * t1[2] + v1[2] * t1[3];
                            u32x2 wa, wb; wa.x = cvt_pk_bf16(a0, a1); wa.y = cvt_pk_bf16(a2, a3); wb.x = cvt_pk_bf16(b0, b1); wb.y = cvt_pk_bf16(b2, b3);
                            bf16_t* qp = o0 + (size_t)row * 3072 + h * 192 + 128 + i0; *(u32x2*)qp = wa; *(u32x2*)(qp + 32) = wb; } }
                    asm volatile("" ::: "memory");
                }
        } else {
            const int h = u.pn;
#pragma unroll
            for (int ai = 0; ai < 2; ++ai)
#pragma unroll
                for (int m = 0; m < 4; ++m) { const int row = row0 + ai * 128 + m * 16;
                    const f32x4 pa = *(const f32x4*)(f0 + (size_t)row * 16 + 8), pb = *(const f32x4*)(f0 + (size_t)row * 16 + 12);
                    const float ssq = ((pa[0] + pa[1]) + (pa[2] + pa[3])) + ((pb[0] + pb[1]) + (pb[2] + pb[3]));
                    const float sc = 1.0f / sqrtf(ssq * (1.0f / 512.0f) + 1e-6f);
                    { const f32x4 v0 = acc[ai][0][m][0] * sc, v1 = acc[ai][0][m][1] * sc; *(u32x4*)(o0 + (size_t)row * 2048 + h * 128 + wc * 32 + 8 * fq) = pack8(v0, v1); }
                    { const f32x4 v0 = acc[ai][1][m][0] * sc, v1 = acc[ai][1][m][1] * sc; const int b = row >> 13, t = row & 8191, dv = wc * 32 + 8 * fq;
                        bf16_t* vp = o1 + ((size_t)((b * 16 + h) * 128 + dv)) * 8192 + t; const u32x4 w = pack8(v0, v1);
                        vp[0] = (bf16_t)(w.x & 0xffff); vp[8192] = (bf16_t)(w.x >> 16); vp[2 * 8192] = (bf16_t)(w.y & 0xffff); vp[3 * 8192] = (bf16_t)(w.y >> 16);
                        vp[4 * 8192] = (bf16_t)(w.z & 0xffff); vp[5 * 8192] = (bf16_t)(w.z >> 16); vp[6 * 8192] = (bf16_t)(w.w & 0xffff); vp[7 * 8192] = (bf16_t)(w.w >> 16); }
                    asm volatile("" ::: "memory");
                }
        }
#undef EPI_BEGIN
#undef EPI_END
    }
};

__device__ __forceinline__ int colmap(int kind, int n, int Nsrc) {
    if (kind == 1) { if (n < 1024) return n; if (n >= 1088) return -1; const int j = n - 1024; return 1024 + (j >> 1) + 32 * (j & 1); }
    if (kind == 2) { if (n < 2048) return (n >> 7) * 192 + (n & 127); const int j = n - 2048, h = j >> 6, jj = j & 63; return h * 192 + 128 + (jj >> 1) + 32 * (jj & 1); }
    return n < Nsrc ? n : -1;
}
__device__ __forceinline__ void transpose_w(const float* W, int Ksrc, int Nsrc, bf16_t* WT, int ldwt, int Ndst, int kind, const float* rscale, LAS float* scr, int gw, int NGW, int lane) {
    const int nblk = Ndst / 64, nitems = (Ksrc / 64) * nblk;
    const int nl = (lane & 15) * 4, kr = lane >> 4, c = lane & 7;
    if (kind == 0 && Ndst <= Nsrc) {
        f32x4 cur[16], nxt[16];
        int item = gw;
        if (item < nitems) { const int k0 = 64 * (item / nblk), n0 = 64 * (item % nblk);
#pragma unroll
            for (int i = 0; i < 16; ++i) cur[i] = *(const f32x4*)(W + (size_t)(k0 + 4 * i + kr) * Nsrc + n0 + nl); }
        for (; item < nitems; item += NGW) {
            const int k0 = 64 * (item / nblk), n0 = 64 * (item % nblk); const int nit = item + NGW;
            if (nit < nitems) { const int k1 = 64 * (nit / nblk), n1 = 64 * (nit % nblk);
#pragma unroll
                for (int i = 0; i < 16; ++i) nxt[i] = *(const f32x4*)(W + (size_t)(k1 + 4 * i + kr) * Nsrc + n1 + nl); }
#pragma unroll
            for (int i = 0; i < 16; ++i) { const int kk = 4 * i + kr; f32x4 v = cur[i]; if (rscale) v = v * rscale[k0 + kk];
                LAS float* d = scr + kk * 65 + nl; d[0] = v[0]; d[1] = v[1]; d[2] = v[2]; d[3] = v[3]; }
            asm volatile("s_waitcnt lgkmcnt(0)" ::: "memory");
#pragma unroll
            for (int j = 0; j < 8; ++j) { const int n = (lane >> 3) + 8 * j; const LAS float* sp = scr + (8 * c) * 65 + n;
                u32x4 o; o.x = cvt_pk_bf16(sp[0 * 65], sp[1 * 65]); o.y = cvt_pk_bf16(sp[2 * 65], sp[3 * 65]); o.z = cvt_pk_bf16(sp[4 * 65], sp[5 * 65]); o.w = cvt_pk_bf16(sp[6 * 65], sp[7 * 65]);
                *(u32x4*)(WT + (size_t)(n0 + n) * ldwt + k0 + 8 * c) = o; }
            asm volatile("s_waitcnt lgkmcnt(0)" ::: "memory");
#pragma unroll
            for (int i = 0; i < 16; ++i) cur[i] = nxt[i];
        }
        return;
    }
    for (int item = gw; item < nitems; item += NGW) {
        const int kb = item / nblk, nb = item % nblk, k0 = 64 * kb, n0 = 64 * nb;
        if (kind == 0 && n0 + 64 <= Nsrc) {
#pragma unroll 4
            for (int i = 0; i < 16; ++i) { const int kk = 4 * i + kr; f32x4 v = *(const f32x4*)(W + (size_t)(k0 + kk) * Nsrc + n0 + nl); if (rscale) v = v * rscale[k0 + kk];
                LAS float* d = scr + kk * 65 + nl; d[0] = v[0]; d[1] = v[1]; d[2] = v[2]; d[3] = v[3]; }
        } else {
            int src[4];
#pragma unroll
            for (int e = 0; e < 4; ++e) src[e] = colmap(kind, n0 + nl + e, Nsrc);
#pragma unroll 4
            for (int i = 0; i < 16; ++i) { const int kk = 4 * i + kr; const float rs = rscale ? rscale[k0 + kk] : 1.0f; LAS float* d = scr + kk * 65 + nl;
#pragma unroll
                for (int e = 0; e < 4; ++e) d[e] = (src[e] >= 0) ? W[(size_t)(k0 + kk) * Nsrc + src[e]] * rs : 0.f; }
        }
        asm volatile("s_waitcnt lgkmcnt(0)" ::: "memory");
#pragma unroll
        for (int j = 0; j < 8; ++j) { const int n = (lane >> 3) + 8 * j; const LAS float* sp = scr + (8 * c) * 65 + n;
            u32x4 o; o.x = cvt_pk_bf16(sp[0 * 65], sp[1 * 65]); o.y = cvt_pk_bf16(sp[2 * 65], sp[3 * 65]); o.z = cvt_pk_bf16(sp[4 * 65], sp[5 * 65]); o.w = cvt_pk_bf16(sp[6 * 65], sp[7 * 65]);
            *(u32x4*)(WT + (size_t)(n0 + n) * ldwt + k0 + 8 * c) = o; }
        asm volatile("s_waitcnt lgkmcnt(0)" ::: "memory");
    }
}
__device__ __forceinline__ void transpose_small(const float* W, bf16_t* WT, int gt, int NGT) {
    for (int idx = gt; idx < 2048 * 32; idx += NGT) { const int n = idx >> 5, k0 = (idx & 31) * 8; float v[8];
#pragma unroll
        for (int e = 0; e < 8; ++e) v[e] = (k0 + e < 96) ? W[(size_t)(k0 + e) * 2048 + n] : 0.f;
        u32x4 o; o.x = cvt_pk_bf16(v[0], v[1]); o.y = cvt_pk_bf16(v[2], v[3]); o.z = cvt_pk_bf16(v[4], v[5]); o.w = cvt_pk_bf16(v[6], v[7]);
        *(u32x4*)(WT + (size_t)n * 256 + k0) = o; }
}
__device__ __forceinline__ void rope_cs(int pos, int i, float& c, float& s) {
    const float fi = (float)i, ph = fi * 0.415241003036499f, pe = __builtin_fmaf(fi, 0.415241003036499f, -ph) + fi * 8.82442119376492e-09f;
    const float inv0 = __builtin_amdgcn_exp2f(-ph), inv = inv0 - inv0 * 0.69314718f * pe;
    const float fp = (float)pos, p = fp * inv, pe2 = __builtin_fmaf(fp, inv, -p);
    const float kq = __builtin_rintf(p * 0.636619772f); const int q = (int)kq;
    float r = __builtin_fmaf(-kq, 1.5707963705062866f, p); r = __builtin_fmaf(-kq, -4.371138828673793e-08f, r); r += pe2;
    const float r2 = r * r;
    float sp = 2.7557319e-06f; sp = sp * r2 - 1.9841270e-04f; sp = sp * r2 + 8.3333333e-03f; sp = sp * r2 - 1.6666667e-01f;
    const float sn = r + r * r2 * sp;
    float cp = -2.7557319e-07f; cp = cp * r2 + 2.4801587e-05f; cp = cp * r2 - 1.3888889e-03f; cp = cp * r2 + 4.1666667e-02f; cp = cp * r2 - 0.5f;
    const float cs = 1.0f + r2 * cp;
    const int qq = q & 3;
    c = (qq == 0) ? cs : (qq == 1) ? -sn : (qq == 2) ? -cs : sn;
    s = (qq == 0) ? sn : (qq == 1) ? cs : (qq == 2) ? -sn : -cs;
}
__device__ __forceinline__ float wave_sum2(float v) { v = sum16(v); v += __shfl_xor(v, 16); v += __shfl_xor(v, 32); return v; }
__device__ __forceinline__ void ln_rows4(const float* y0, const float* g, const float* b, float* h0, bf16_t* hb0, float* st0, bool final, int lane) {
    const f32x4* yr = (const f32x4*)y0 + lane; f32x4 v[4][8]; float s[4], q[4], mu[4], rs[4];
#pragma unroll
    for (int i = 0; i < 4; ++i)
#pragma unroll
        for (int j = 0; j < 8; ++j) v[i][j] = yr[512 * i + 64 * j];
#pragma unroll
    for (int i = 0; i < 4; ++i) { s[i] = 0.f;
#pragma unroll
        for (int j = 0; j < 8; ++j) s[i] += (v[i][j][0] + v[i][j][1]) + (v[i][j][2] + v[i][j][3]); }
#pragma unroll
    for (int i = 0; i < 4; ++i) mu[i] = wave_sum2(s[i]) * (1.f / 2048.f);
#pragma unroll
    for (int i = 0; i < 4; ++i) { q[i] = 0.f;
#pragma unroll
        for (int j = 0; j < 8; ++j) { v[i][j] = v[i][j] - mu[i]; q[i] += (v[i][j][0] * v[i][j][0] + v[i][j][1] * v[i][j][1]) + (v[i][j][2] * v[i][j][2] + v[i][j][3] * v[i][j][3]); } }
#pragma unroll
    for (int i = 0; i < 4; ++i) rs[i] = 1.0f / sqrtf(wave_sum2(q[i]) * (1.f / 2048.f) + 1e-5f);
    if (!final && lane == 0) { *(f32x4*)st0 = (f32x4){mu[0], rs[0], mu[1], rs[1]}; *(f32x4*)(st0 + 4) = (f32x4){mu[2], rs[2], mu[3], rs[3]}; }
#pragma unroll
    for (int j = 0; j < 8; ++j) { const f32x4 gg = ((const f32x4*)g)[lane + 64 * j], bb = ((const f32x4*)b)[lane + 64 * j];
#pragma unroll
        for (int i = 0; i < 4; ++i) { const f32x4 o = v[i][j] * rs[i] * gg + bb;
            if (final) ((f32x4*)h0)[512 * i + lane + 64 * j] = o;
            else { u32x2 w; w.x = cvt_pk_bf16(o[0], o[1]); w.y = cvt_pk_bf16(o[2], o[3]); ((u32x2*)hb0)[512 * i + lane + 64 * j] = w; } } }
}

__device__ __forceinline__ void ln_mix_rows4(const float* y0, int row0, const float* g, const float* b, const float* mix, bf16_t* X6, float* st0, int lane) {
    asm volatile("" : "+v"(lane));
    const f32x4* yr = (const f32x4*)y0 + lane;
    const bool has_prev = (row0 & 8191) != 0; float mp = 0.f, rp = 0.f;
    if (has_prev) { float s = 0.f, q = 0.f; f32x4 t[8];
#pragma unroll
        for (int j = 0; j < 8; ++j) { t[j] = yr[64 * j - 512]; s += (t[j][0] + t[j][1]) + (t[j][2] + t[j][3]); }
        mp = wave_sum2(s) * (1.f / 2048.f);
#pragma unroll
        for (int j = 0; j < 8; ++j) { t[j] = t[j] - mp; q += (t[j][0] * t[j][0] + t[j][1] * t[j][1]) + (t[j][2] * t[j][2] + t[j][3] * t[j][3]); }
        rp = 1.0f / sqrtf(wave_sum2(q) * (1.f / 2048.f) + 1e-5f); }
    asm volatile("" ::: "memory");
    f32x4 v[4][8]; float s[4], q[4], mu[4], rs[4];
#pragma unroll
    for (int i = 0; i < 4; ++i)
#pragma unroll
        for (int j = 0; j < 8; ++j) v[i][j] = yr[512 * i + 64 * j];
#pragma unroll
    for (int i = 0; i < 4; ++i) { s[i] = 0.f;
#pragma unroll
        for (int j = 0; j < 8; ++j) s[i] += (v[i][j][0] + v[i][j][1]) + (v[i][j][2] + v[i][j][3]); }
#pragma unroll
    for (int i = 0; i < 4; ++i) mu[i] = wave_sum2(s[i]) * (1.f / 2048.f);
#pragma unroll
    for (int i = 0; i < 4; ++i) { q[i] = 0.f;
#pragma unroll
        for (int j = 0; j < 8; ++j) { v[i][j] = v[i][j] - mu[i]; q[i] += (v[i][j][0] * v[i][j][0] + v[i][j][1] * v[i][j][1]) + (v[i][j][2] * v[i][j][2] + v[i][j][3] * v[i][j][3]); } }
#pragma unroll
    for (int i = 0; i < 4; ++i) rs[i] = 1.0f / sqrtf(wave_sum2(q[i]) * (1.f / 2048.f) + 1e-5f);
    if (lane == 0) { *(f32x4*)st0 = (f32x4){mu[0], rs[0], mu[1], rs[1]}; *(f32x4*)(st0 + 4) = (f32x4){mu[2], rs[2], mu[3], rs[3]}; }
#pragma unroll
    for (int j = 0; j < 8; ++j) { int pc = lane + 64 * j; asm volatile("" : "+v"(pc)); const f32x4 gg = ((const f32x4*)g)[pc], bb = ((const f32x4*)b)[pc];
        f32x4 hp = {0.f, 0.f, 0.f, 0.f}; if (has_prev) hp = (yr[64 * j - 512] - mp) * rp * gg + bb;
        f32x4 h[4];
#pragma unroll
        for (int i = 0; i < 4; ++i) h[i] = v[i][j] * rs[i] * gg + bb;
#pragma unroll
        for (int sl = 0; sl < 6; ++sl) { const int mr = (sl == 0) ? 0 : (sl == 1) ? 2 : (sl == 2) ? 3 : (sl == 3) ? 1 : sl; const f32x4 m4 = ((const f32x4*)(mix + mr * 2048))[pc];
#pragma unroll
            for (int i = 0; i < 4; ++i) { const f32x4 pv = (i == 0) ? hp : h[i - 1]; const f32x4 o = h[i] + (pv - h[i]) * m4;
                u32x2 w; w.x = cvt_pk_bf16(o[0], o[1]); w.y = cvt_pk_bf16(o[2], o[3]);
                ((u32x2*)(X6 + (size_t)sl * (SLOT / 2) + (size_t)(row0 + i) * 2048))[pc] = w; } }
        asm volatile("" ::: "memory"); }
}

constexpr int MK_STRIDE = 400, MV_STRIDE = 144, MK_BYTES = 64 * MK_STRIDE, MV_BYTES = 128 * MV_STRIDE, MBUF = MK_BYTES + MV_BYTES;
__device__ __forceinline__ void mla_attn_phase(LAS unsigned char* lds, const bf16_t* Q, const bf16_t* KN, const bf16_t* KR, const bf16_t* VT, bf16_t* O, int G, int bx, const int tid) {
    const int lane = tid & 63, wid = __builtin_amdgcn_readfirstlane(tid >> 6), r32 = lane & 31, hi = lane >> 5;
    const int vcu = (G % 8 == 0) ? (bx % 8) * (G / 8) + bx / 8 : bx;
    for (int ui = 0;; ++ui) {
        int bh, qb;
        if (G == 256) { if (ui >= 4) break; const int s = vcu & 7; bh = vcu >> 3; qb = (ui == 0) ? s : (ui == 1) ? 15 - s : (ui == 2) ? 16 + s : 31 - s; }
        else { const int L = ui * G + bx; if (L >= 1024) break; bh = L & 31; qb = 31 - (L >> 5); }
        const int b = bh >> 4, h = bh & 15; const size_t rowbase = (size_t)b * SEQ; const int q0 = qb * 256 + wid * 32;
        bf16x8 qf[12];
        { const bf16_t* qp = Q + (rowbase + q0 + r32) * 3072 + h * 192 + hi * 8;
#pragma unroll
            for (int d0 = 0; d0 < 12; ++d0) qf[d0] = *(const bf16x8*)(qp + d0 * 16); }
        const int NT = 4 * (qb + 1);
        f32x16 o[4];
#pragma unroll
        for (int i = 0; i < 4; ++i)
#pragma unroll
            for (int r = 0; r < 16; ++r) o[i][r] = 0.f;
        float mrun = -1e30f, lrun = 0.f;
        u32x4 kreg[3], vreg[2];
        const int kkey = tid >> 4, kpc = tid & 15, rkey = tid >> 3, rpc = tid & 7;
        const bf16_t* kn0 = KN + (rowbase + kkey) * 2048 + h * 128 + kpc * 8;
        const bf16_t* kr0 = KR + (rowbase + rkey) * 64 + rpc * 8;
        const bf16_t* vt0 = VT + ((size_t)(bh * 128 + (tid >> 3))) * 8192 + (tid & 7) * 8;
#define MLA_LOAD(j) do { kreg[0] = *(const u32x4*)(kn0 + (size_t)(64 * (j)) * 2048); kreg[1] = *(const u32x4*)(kn0 + (size_t)(64 * (j) + 32) * 2048); kreg[2] = *(const u32x4*)(kr0 + (size_t)(64 * (j)) * 64); \
        vreg[0] = *(const u32x4*)(vt0 + 64 * (j)); vreg[1] = *(const u32x4*)(vt0 + (size_t)64 * 8192 + 64 * (j)); } while (0)
#define MLA_STORE(buf) do { LAS unsigned char* kb_ = lds + (buf) * MBUF; LAS unsigned char* vb_ = kb_ + MK_BYTES; \
        *(LAS u32x4*)(kb_ + kkey * MK_STRIDE + kpc * 16) = kreg[0]; *(LAS u32x4*)(kb_ + (kkey + 32) * MK_STRIDE + kpc * 16) = kreg[1]; *(LAS u32x4*)(kb_ + rkey * MK_STRIDE + 256 + rpc * 16) = kreg[2]; \
        { LAS unsigned char* p_ = vb_ + (tid >> 3) * MV_STRIDE + ((tid & 7) >> 1) * 32 + (tid & 1) * 8; *(LAS u32x2*)p_ = (u32x2){vreg[0].x, vreg[0].y}; *(LAS u32x2*)(p_ + 16) = (u32x2){vreg[0].z, vreg[0].w}; \
          p_ += 64 * MV_STRIDE; *(LAS u32x2*)p_ = (u32x2){vreg[1].x, vreg[1].y}; *(LAS u32x2*)(p_ + 16) = (u32x2){vreg[1].z, vreg[1].w}; } } while (0)
        MLA_LOAD(0); MLA_STORE(0);
        __syncthreads();
        for (int j = 0; j < NT; ++j) {
            const int buf = j & 1;
            if (j + 1 < NT) MLA_LOAD(j + 1);
            if (64 * j <= q0 + 31) {
                const LAS unsigned char* kb = lds + buf * MBUF; const LAS unsigned char* vb = kb + MK_BYTES;
                f32x16 st[2];
#pragma unroll
                for (int kvh = 0; kvh < 2; ++kvh)
#pragma unroll
                    for (int r = 0; r < 16; ++r) st[kvh][r] = 0.f;
                { const LAS unsigned char* kp0 = kb + r32 * MK_STRIDE + hi * 16; const LAS unsigned char* kp1 = kp0 + 32 * MK_STRIDE;
#define MLA_KF(i) (*(const LAS bf16x8*)((((i) & 1) ? kp1 : kp0) + ((i) >> 1) * 32))
                    bf16x8 kq[6];
#pragma unroll
                    for (int i = 0; i < 6; ++i) kq[i] = MLA_KF(i);
                    __builtin_amdgcn_sched_barrier(0);
#pragma unroll
                    for (int i = 0; i < 24; ++i) { st[i & 1] = __builtin_amdgcn_mfma_f32_32x32x16_bf16(kq[i % 6], qf[i >> 1], st[i & 1], 0, 0, 0);
                        if (i + 6 < 24) kq[i % 6] = MLA_KF(i + 6);
                        __builtin_amdgcn_sched_barrier(0); }
#undef MLA_KF
                }
                if (64 * j + 63 > q0) {
                    const int qg = q0 + r32;
#pragma unroll
                    for (int kvh = 0; kvh < 2; ++kvh)
#pragma unroll
                        for (int r = 0; r < 16; ++r) { const int kg = 64 * j + 32 * kvh + crow(r, hi); if (kg > qg) st[kvh][r] = -1e30f; }
                }
                const LAS unsigned char* vp0 = vb + r32 * MV_STRIDE + hi * 16;
#define MLA_VF(i) (*(const LAS bf16x8*)(vp0 + ((i) & 3) * (32 * MV_STRIDE) + ((i) >> 2) * 32))
                bf16x8 vq[4];
#pragma unroll
                for (int i = 0; i < 4; ++i) vq[i] = MLA_VF(i);
                float mx = st[0][0];
#pragma unroll
                for (int r = 1; r < 16; ++r) mx = fmaxf(mx, st[0][r]);
#pragma unroll
                for (int r = 0; r < 16; ++r) mx = fmaxf(mx, st[1][r]);
                mx = fmaxf(mx, __shfl_xor(mx, 32));
                const float mnew = (mx > mrun + 8.0f) ? mx : mrun;
                if (__any(mnew != mrun)) { const float alpha = __builtin_amdgcn_exp2f(mrun - mnew); lrun *= alpha;
#pragma unroll
                    for (int i = 0; i < 4; ++i)
#pragma unroll
                        for (int r = 0; r < 16; ++r) o[i][r] *= alpha;
                    mrun = mnew; }
                float ps = 0.f;
#pragma unroll
                for (int kvh = 0; kvh < 2; ++kvh)
#pragma unroll
                    for (int r = 0; r < 16; ++r) { const float p = __builtin_amdgcn_exp2f(st[kvh][r] - mrun); st[kvh][r] = p; ps += p; }
                lrun += ps;
                bf16x8 pf[4];
#pragma unroll
                for (int ks = 0; ks < 4; ++ks) { const int kvh = ks >> 1, rb = 8 * (ks & 1); u32x4 w;
                    w.x = cvt_pk_bf16(st[kvh][rb + 0], st[kvh][rb + 1]); w.y = cvt_pk_bf16(st[kvh][rb + 2], st[kvh][rb + 3]); w.z = cvt_pk_bf16(st[kvh][rb + 4], st[kvh][rb + 5]); w.w = cvt_pk_bf16(st[kvh][rb + 6], st[kvh][rb + 7]);
                    pf[ks] = __builtin_bit_cast(bf16x8, w); }
                __builtin_amdgcn_sched_barrier(0);
#pragma unroll
                for (int i = 0; i < 16; ++i) { o[i & 3] = __builtin_amdgcn_mfma_f32_32x32x16_bf16(vq[i % 4], pf[i >> 2], o[i & 3], 0, 0, 0);
                    if (i + 4 < 16) vq[i % 4] = MLA_VF(i + 4);
                    __builtin_amdgcn_sched_barrier(0); }
#undef MLA_VF
            }
            if (j + 1 < NT) MLA_STORE(buf ^ 1);
            __syncthreads();
        }
        lrun += __shfl_xor(lrun, 32);
        const float inv = 1.0f / lrun;
        bf16_t* op = O + (rowbase + q0 + r32) * 2048 + h * 128 + 4 * hi;
#pragma unroll
        for (int dvb = 0; dvb < 4; ++dvb)
#pragma unroll
            for (int g4 = 0; g4 < 4; ++g4) { u32x2 w; w.x = cvt_pk_bf16(o[dvb][4 * g4] * inv, o[dvb][4 * g4 + 1] * inv); w.y = cvt_pk_bf16(o[dvb][4 * g4 + 2] * inv, o[dvb][4 * g4 + 3] * inv);
                *(u32x2*)(op + 32 * dvb + 8 * g4) = w; }
#undef MLA_LOAD
#undef MLA_STORE
    }
}

constexpr int SK_STRIDE = 144, SV_STRIDE = 520, SK_BYTES = 256 * SK_STRIDE, SV_BYTES = 64 * SV_STRIDE, SB_OFF = SK_BYTES + SV_BYTES;
__device__ __forceinline__ void swa_attn_phase(LAS unsigned char* lds, const bf16_t* Q, const bf16_t* Kg, const bf16_t* VT, bf16_t* O, const float* bt2, const float* sinks, int G, int bx, const int tid) {
    const int lane = tid & 63, wid = __builtin_amdgcn_readfirstlane(tid >> 6), r32 = lane & 31, hi = lane >> 5;
    LAS unsigned char* ks_ = lds; LAS unsigned char* vs_ = lds + SK_BYTES; LAS float* bs_ = (LAS float*)(lds + SB_OFF);
    for (int L = bx; L < 512; L += G) {
        const int hk = L & 3, blk = (L >> 2) & 63, b = L >> 8;
        const size_t rowbase = (size_t)b * SEQ; const int t0 = blk * 128 - 128;
#pragma unroll
        for (int i = 0; i < 4; ++i) { const int p = tid + 512 * i, key = p >> 3, pc = p & 7; u32x4 v = {0u, 0u, 0u, 0u};
            if (t0 + key >= 0) v = *(const u32x4*)(Kg + (rowbase + t0 + key) * 256 + hk * 64 + pc * 8);
            *(LAS u32x4*)(ks_ + key * SK_STRIDE + pc * 16) = v; }
#pragma unroll
        for (int i = 0; i < 4; ++i) { const int p = tid + 512 * i, dv = p >> 5, pc = p & 31; u32x4 v = {0u, 0u, 0u, 0u};
            if (t0 + pc * 8 >= 0) v = *(const u32x4*)(VT + ((size_t)((b * 4 + hk) * 64 + dv)) * 8192 + t0 + pc * 8);
            LAS unsigned char* p_ = vs_ + dv * SV_STRIDE + pc * 16; *(LAS u32x2*)p_ = (u32x2){v.x, v.y}; *(LAS u32x2*)(p_ + 8) = (u32x2){v.z, v.w}; }
        for (int i = tid; i < 1024; i += 512) bs_[i] = bt2[(hk * 8) * 128 + i];
        __syncthreads();
        for (int ci = 0; ci < 4; ++ci) {
            const int c = wid + 8 * ci, g = c >> 2, qs = c & 3, head = hk * 8 + g;
            const size_t qrow = rowbase + blk * 128 + 32 * qs + r32;
            bf16x8 qf[4];
#pragma unroll
            for (int d0 = 0; d0 < 4; ++d0) qf[d0] = *(const bf16x8*)(Q + qrow * 2048 + head * 64 + d0 * 16 + hi * 8);
            const float sink2 = sinks[head] * LOG2E;
            float mrun = sink2, lrun = (hi == 0) ? 1.0f : 0.0f;
            f32x16 o[2];
#pragma unroll
            for (int i = 0; i < 2; ++i)
#pragma unroll
                for (int r = 0; r < 16; ++r) o[i][r] = 0.f;
#pragma unroll 1
            for (int kb = 0; kb < 5; ++kb) {
                f32x16 st;
#pragma unroll
                for (int r = 0; r < 16; ++r) st[r] = 0.f;
                const LAS unsigned char* kp_ = ks_ + (32 * (qs + kb) + r32) * SK_STRIDE + hi * 16;
#pragma unroll
                for (int d0 = 0; d0 < 4; ++d0) { const bf16x8 kf = *(const LAS bf16x8*)(kp_ + d0 * 32); st = __builtin_amdgcn_mfma_f32_32x32x16_bf16(kf, qf[d0], st, 0, 0, 0); }
                float mx = -1e30f;
#pragma unroll
                for (int r = 0; r < 16; ++r) { const int kl = 32 * kb + crow(r, hi);
                    const int dist = r32 + 128 - kl; const bool ok = (dist >= 0) && (dist < 128) && (t0 + 32 * qs + kl >= 0);
                    const float bv = bs_[g * 128 + (dist & 127)];
                    const float sv = ok ? st[r] + bv : -1e30f; st[r] = sv; mx = fmaxf(mx, sv); }
                mx = fmaxf(mx, __shfl_xor(mx, 32));
                const float mnew = fmaxf(mrun, mx), alpha = __builtin_amdgcn_exp2f(mrun - mnew); mrun = mnew;
                float ps = 0.f;
#pragma unroll
                for (int r = 0; r < 16; ++r) { const float p = __builtin_amdgcn_exp2f(st[r] - mnew); st[r] = p; ps += p; }
                lrun = lrun * alpha + ps;
#pragma unroll
                for (int i = 0; i < 2; ++i)
#pragma unroll
                    for (int r = 0; r < 16; ++r) o[i][r] *= alpha;
#pragma unroll
                for (int k2 = 0; k2 < 2; ++k2) { const int rb = 8 * k2; u32x4 w;
                    w.x = cvt_pk_bf16(st[rb + 0], st[rb + 1]); w.y = cvt_pk_bf16(st[rb + 2], st[rb + 3]); w.z = cvt_pk_bf16(st[rb + 4], st[rb + 5]); w.w = cvt_pk_bf16(st[rb + 6], st[rb + 7]);
                    const bf16x8 pf = __builtin_bit_cast(bf16x8, w);
#pragma unroll
                    for (int dvb = 0; dvb < 2; ++dvb) { const LAS unsigned char* vp = vs_ + (32 * dvb + r32) * SV_STRIDE + (32 * (qs + kb) + 16 * k2 + 4 * hi) * 2;
                        const u32x2 lo = *(const LAS u32x2*)vp, hi2 = *(const LAS u32x2*)(vp + 16); const u32x4 vw = {lo.x, lo.y, hi2.x, hi2.y};
                        o[dvb] = __builtin_amdgcn_mfma_f32_32x32x16_bf16(__builtin_bit_cast(bf16x8, vw), pf, o[dvb], 0, 0, 0); } }
            }
            lrun += __shfl_xor(lrun, 32);
            const float inv = 1.0f / lrun;
            bf16_t* op = O + qrow * 2048 + head * 64 + 4 * hi;
#pragma unroll
            for (int dvb = 0; dvb < 2; ++dvb)
#pragma unroll
                for (int g4 = 0; g4 < 4; ++g4) { u32x2 w; w.x = cvt_pk_bf16(o[dvb][4 * g4] * inv, o[dvb][4 * g4 + 1] * inv); w.y = cvt_pk_bf16(o[dvb][4 * g4 + 2] * inv, o[dvb][4 * g4 + 3] * inv);
                    *(u32x2*)(op + 32 * dvb + 8 * g4) = w; }
        }
        __syncthreads();
    }
}

__device__ __forceinline__ void rwkv_mix_phase(const float* y, const float* stats, const float* lg, const float* lb, const float* mix, bf16_t* X6, int gt, int NGT) {
    for (int idx = gt; idx < M * 256; idx += NGT) { const int row = idx >> 8, c = (idx & 255) * 8; const size_t off = (size_t)row * 2048 + c;
        const f32x4 g0 = *(const f32x4*)(lg + c), g1 = *(const f32x4*)(lg + c + 4), b0 = *(const f32x4*)(lb + c), b1 = *(const f32x4*)(lb + c + 4);
        const f32x2 ms = *(const f32x2*)(stats + 2 * (size_t)row);
        const f32x4 x0 = (*(const f32x4*)(y + off) - ms[0]) * ms[1] * g0 + b0, x1 = (*(const f32x4*)(y + off + 4) - ms[0]) * ms[1] * g1 + b1; f32x4 p0 = {0.f, 0.f, 0.f, 0.f}, p1 = p0;
        if ((row & 8191) != 0) { const f32x2 mp = *(const f32x2*)(stats + 2 * (size_t)row - 2); p0 = (*(const f32x4*)(y + off - 2048) - mp[0]) * mp[1] * g0 + b0; p1 = (*(const f32x4*)(y + off - 2044) - mp[0]) * mp[1] * g1 + b1; }
        const f32x4 d0 = p0 - x0, d1 = p1 - x1;
#pragma unroll
        for (int s = 0; s < 6; ++s) { const int mr = (s == 0) ? 0 : (s == 1) ? 2 : (s == 2) ? 3 : (s == 3) ? 1 : s;
            const f32x4 m0 = *(const f32x4*)(mix + mr * 2048 + c), m1 = *(const f32x4*)(mix + mr * 2048 + c + 4);
            *(u32x4*)(X6 + (size_t)s * (SLOT / 2) + off) = pack8(x0 + d0 * m0, x1 + d1 * m1); }
    }
}
constexpr int SC_T = 32, SC_TOK = 1536, SC_BUF = SC_T * SC_TOK;
__device__ __forceinline__ void rwkv_scan_phase(LAS unsigned char* lds, const bf16_t* RKV, const float* DEC, const float* AF, const float* k_k, const float* k_a, const float* r_k, float* BON, float* Y, int bx, const int tid) {
    const int lane = tid & 63, wid = __builtin_amdgcn_readfirstlane(tid >> 6);
    const int bh = bx >> 2, rq = bx & 3, b = bh >> 5, h = bh & 31; const size_t rowbase = (size_t)b * SEQ;
    const int ptid = tid - 256, ptok = ptid >> 4, pc4 = (ptid & 15) * 4;
    f32x4 kk4 = {0.f, 0.f, 0.f, 0.f}, ka4 = kk4, rk4 = kk4;
    if (wid >= 4) { kk4 = *(const f32x4*)(k_k + h * 64 + pc4); ka4 = *(const f32x4*)(k_a + h * 64 + pc4); rk4 = *(const f32x4*)(r_k + h * 64 + pc4); }
    u32x2 prw[2], pkw[2], pvw[2]; f32x4 pw4[2], pa4[2];
#pragma unroll
    for (int i = 0; i < 2; ++i) { prw[i] = (u32x2){0u, 0u}; pkw[i] = prw[i]; pvw[i] = prw[i]; pw4[i] = (f32x4){0.f, 0.f, 0.f, 0.f}; pa4[i] = pw4[i]; }
#define SCAN_LOAD(c) do { _Pragma("unroll") for (int ps_ = 0; ps_ < 2; ++ps_) { const int tl = ptok + 16 * ps_; const size_t off = (rowbase + (size_t)(c) * SC_T + tl) * 2048 + h * 64 + pc4; \
        prw[ps_] = *(const u32x2*)(RKV + off); pkw[ps_] = *(const u32x2*)(RKV + (SLOT / 2) + off); pvw[ps_] = *(const u32x2*)(RKV + 2 * (SLOT / 2) + off); \
        pw4[ps_] = *(const f32x4*)(DEC + off); pa4[ps_] = *(const f32x4*)(AF + off); } } while (0)
#define SCAN_STORE(buf, c) do { _Pragma("unroll") for (int ps_ = 0; ps_ < 2; ++ps_) { const int tl = ptok + 16 * ps_; const u32x2 rw = prw[ps_], kw = pkw[ps_], vw = pvw[ps_]; const f32x4 w4 = pw4[ps_], a4 = pa4[ps_]; \
        const f32x4 r4 = {bflo(rw.x), bfhi(rw.x), bflo(rw.y), bfhi(rw.y)}, k4 = {bflo(kw.x), bfhi(kw.x), bflo(kw.y), bfhi(kw.y)}, v4 = {bflo(vw.x), bfhi(vw.x), bflo(vw.y), bfhi(vw.y)}; \
        const f32x4 kr = k4 * kk4; float ss = (kr[0] * kr[0] + kr[1] * kr[1]) + (kr[2] * kr[2] + kr[3] * kr[3]); ss = sum16(ss); \
        const float rn = 1.0f / fmaxf(sqrtf(ss), 1e-12f); const f32x4 kn = kr * rn; const f32x4 kp = k4 * (1.0f + (a4 - 1.0f) * ka4); \
        { const f32x4 tb = r4 * kp * rk4; const float bon = sum16((tb[0] + tb[1]) + (tb[2] + tb[3])); if (rq == 0 && pc4 == 0) BON[(rowbase + (size_t)(c) * SC_T + tl) * 32 + h] = bon; } \
        LAS unsigned char* d_ = lds + (buf) * SC_BUF + tl * SC_TOK + pc4 * 4; \
        *(LAS f32x4*)(d_) = r4; *(LAS f32x4*)(d_ + 256) = w4; *(LAS f32x4*)(d_ + 512) = kp; *(LAS f32x4*)(d_ + 768) = v4; *(LAS f32x4*)(d_ + 1024) = -kn; *(LAS f32x4*)(d_ + 1280) = kn * a4; } } while (0)
    const int ks4 = (lane & 15) * 16, rowi = 16 * rq + 4 * wid + (lane >> 4);
    f32x2 S01 = {0.f, 0.f}, S23 = {0.f, 0.f};
    float* yp = Y + rowbase * 2048 + h * 64 + rowi;
    if (wid >= 4) { SCAN_LOAD(0); SCAN_STORE(0, 0); SCAN_LOAD(1); }
    __syncthreads();
    for (int c = 0; c < SEQ / SC_T; ++c) {
        if (wid >= 4) { if (c + 1 < SEQ / SC_T) { SCAN_STORE((c + 1) & 1, c + 1); if (c + 2 < SEQ / SC_T) SCAN_LOAD(c + 2); } }
        else {
            const LAS unsigned char* base = lds + (c & 1) * SC_BUF + ks4; const LAS unsigned char* vbase = lds + (c & 1) * SC_BUF + 768 + rowi * 4;
            f32x4 r4 = *(const LAS f32x4*)(base), w4 = *(const LAS f32x4*)(base + 256), k4 = *(const LAS f32x4*)(base + 512), a4 = *(const LAS f32x4*)(base + 1024), b4 = *(const LAS f32x4*)(base + 1280);
            float vv = *(const LAS float*)(vbase); float ykeep = 0.f;
#pragma unroll
            for (int t = 0; t < SC_T; ++t) {
                f32x4 r4n = r4, w4n = w4, k4n = k4, a4n = a4, b4n = b4; float vvn = vv;
                if (t + 1 < SC_T) { const LAS unsigned char* p = base + (t + 1) * SC_TOK;
                    r4n = *(const LAS f32x4*)(p); w4n = *(const LAS f32x4*)(p + 256); k4n = *(const LAS f32x4*)(p + 512); a4n = *(const LAS f32x4*)(p + 1024); b4n = *(const LAS f32x4*)(p + 1280);
                    vvn = *(const LAS float*)(vbase + (t + 1) * SC_TOK); }
                const f32x2 a01 = {a4[0], a4[1]}, a23 = {a4[2], a4[3]}, w01 = {w4[0], w4[1]}, w23 = {w4[2], w4[3]}, b01 = {b4[0], b4[1]}, b23 = {b4[2], b4[3]}, k01 = {k4[0], k4[1]}, k23 = {k4[2], k4[3]}, r01 = {r4[0], r4[1]}, r23 = {r4[2], r4[3]};
                const f32x2 tsa = S01 * a01 + S23 * a23; const float sa = sum16(tsa[0] + tsa[1]);
                S01 = S01 * w01 + (b01 * sa + k01 * vv); S23 = S23 * w23 + (b23 * sa + k23 * vv);
                const f32x2 ty = S01 * r01 + S23 * r23; const float y = sum16(ty[0] + ty[1]);
                ykeep = ((lane & 15) == (t & 15)) ? y : ykeep;
                if ((t & 15) == 15) yp[(size_t)(c * SC_T + (t - 15) + (lane & 15)) * 2048] = ykeep;
                r4 = r4n; w4 = w4n; k4 = k4n; a4 = a4n; b4 = b4n; vv = vvn;
            }
        }
        __syncthreads();
    }
#undef SCAN_LOAD
#undef SCAN_STORE
}
__device__ __forceinline__ void rwkv_gn_phase(const float* Y, const bf16_t* Vb, const float* BON, const bf16_t* GB, const float* ln_g, const float* ln_b, bf16_t* YG, int gw, int NGW, int lane) {
    const int c4 = (lane & 15) * 4, sub = lane >> 4;
    for (int it = gw * 4 + sub; it < M * 32; it += NGW * 4) { const int row = it >> 5, h = it & 31; const int ch = h * 64 + c4; const size_t off = (size_t)row * 2048 + ch;
        const f32x4 y4 = *(const f32x4*)(Y + off);
        const u32x2 vw = *(const u32x2*)(Vb + off), gw2 = *(const u32x2*)(GB + off); const float bonus = BON[it];
        const f32x4 lg = *(const f32x4*)(ln_g + ch), lb = *(const f32x4*)(ln_b + ch);
        const float mean = sum16((y4[0] + y4[1]) + (y4[2] + y4[3])) * (1.f / 64.f); const f32x4 d = y4 - mean;
        const float var = sum16((d[0] * d[0] + d[1] * d[1]) + (d[2] * d[2] + d[3] * d[3])) * (1.f / 64.f); const float rstd = 1.0f / sqrtf(var + 64e-5f);
        const f32x4 v4 = {bflo(vw.x), bfhi(vw.x), bflo(vw.y), bfhi(vw.y)}, g4 = {bflo(gw2.x), bfhi(gw2.x), bflo(gw2.y), bfhi(gw2.y)};
        const f32x4 outv = (d * rstd * lg + lb + v4 * bonus) * g4;
        u32x2 w; w.x = cvt_pk_bf16(outv[0], outv[1]); w.y = cvt_pk_bf16(outv[2], outv[3]); *(u32x2*)(YG + off) = w; }
}

#define XB_TMO      128
#define XB_XCNT(j)  (256  + 64 * (j))
#define XB_XSUB(j)  (1280 + 64 * (j))
#define XB_XGEN(j)  (2304 + 64 * (j))
#define XB_TOP      3328
#define XB_TOPGEN   3392
#define XCD_BAR_WORDS 3456
#define XB_SPIN_CAP (1u << 18)
__device__ __forceinline__ unsigned xb_ld(unsigned* p)              { return __hip_atomic_load(p, __ATOMIC_RELAXED, __HIP_MEMORY_SCOPE_AGENT); }
__device__ __forceinline__ unsigned xb_add(unsigned* p, unsigned v) { return __hip_atomic_fetch_add(p, v, __ATOMIC_RELAXED, __HIP_MEMORY_SCOPE_AGENT); }
__device__ __forceinline__ unsigned xb_xcc_id() { return (unsigned)__builtin_amdgcn_s_getreg((3 << 11) | 20) & 0xFu; }
#define XB_SPIN(cond, bar) do { unsigned _sp = 0; while (cond) { __builtin_amdgcn_s_sleep(1); \
    if ((++_sp & 255u) == 0u) { if (xb_ld(&(bar)[XB_TMO])) break; if (_sp > XB_SPIN_CAP) { atomicAdd(&(bar)[XB_TMO], 1u); break; } } } } while (0)
struct XcdBarrier { unsigned* bar; unsigned x; volatile LAS unsigned* st; };
__device__ __forceinline__ XcdBarrier xcd_barrier_post(unsigned* bar, volatile LAS unsigned* st) {
    XcdBarrier b; b.bar = bar; b.x = xb_xcc_id(); b.st = st;
    if (threadIdx.x == 0) (void)xb_add(&bar[XB_XCNT(b.x)], 1u);
    return b;
}
__device__ __forceinline__ void xcd_barrier_complete(unsigned* bar, unsigned x, unsigned& nloc, unsigned& nx) {
    const unsigned G = gridDim.x * gridDim.y * gridDim.z;
    unsigned sum, cnt, mine, sp = 0u;
    for (;;) {
        sum = 0u; cnt = 0u; mine = 0u;
#pragma unroll
        for (unsigned j = 0; j < 16; ++j) { const unsigned c = xb_ld(&bar[XB_XCNT(j)]); sum += c; cnt += (c > 0u) ? 1u : 0u; mine = (j == x) ? c : mine; }
        if (sum == G) break;
        __builtin_amdgcn_s_sleep(1);
        if ((++sp & 255u) == 0u) { if (xb_ld(&bar[XB_TMO])) break; if (sp > XB_SPIN_CAP) { atomicAdd(&bar[XB_TMO], 1u); break; } }
    }
    nloc = mine > 0u ? mine : 1u; nx = cnt > 0u ? cnt : 1u;
}
__device__ __forceinline__ void xcd_barrier(const XcdBarrier& b) {
    asm volatile("s_waitcnt vmcnt(0)" ::: "memory");
    __syncthreads();
    if (threadIdx.x == 0) {
        unsigned* bar = b.bar;
        __builtin_amdgcn_s_waitcnt(0);
        unsigned nloc = b.st[0], nx = b.st[1];
        if (nloc == 0u) { xcd_barrier_complete(bar, b.x, nloc, nx); b.st[0] = nloc; b.st[1] = nx; }
        const unsigned old = xb_add(&bar[XB_XSUB(b.x)], 1u);
        const unsigned gen = old / nloc;
        if (old + 1u == (gen + 1u) * nloc) {
            __builtin_amdgcn_fence(__ATOMIC_RELEASE, "agent");
            asm volatile("s_waitcnt vmcnt(0)" ::: "memory");
            const unsigned og = xb_add(&bar[XB_TOP], 1u);
            const unsigned tg = og / nx;
            if (og + 1u == (tg + 1u) * nx) xb_add(&bar[XB_TOPGEN], 1u);
            else XB_SPIN(xb_ld(&bar[XB_TOPGEN]) == tg, bar);
            __builtin_amdgcn_fence(__ATOMIC_ACQUIRE, "agent");
            xb_add(&bar[XB_XGEN(b.x)], 1u);
            asm volatile("s_waitcnt vmcnt(0)" ::: "memory");
        } else {
            XB_SPIN(xb_ld(&bar[XB_XGEN(b.x)]) == gen, bar);
            __builtin_amdgcn_fence(__ATOMIC_ACQUIRE, "agent");
            asm volatile("s_waitcnt vmcnt(0)" ::: "memory");
        }
    }
    __syncthreads();
}

struct Args { const float* in[33]; float* out; unsigned char* ws; int ph_lo, ph_hi; };
#ifndef PROBE_N
#define PROBE_N 0
#define PROBE_MAP(i) 0
#endif
constexpr int N_PHASES = 36 + PROBE_N;
typedef const __attribute__((address_space(4))) unsigned char* kargp_t;
#define IN(i) (*(const float* const __attribute__((address_space(4)))*)(kp + 8 * (i)))
__global__ void __launch_bounds__(512, 2) hybrid_fwd(Args args) {
    extern __shared__ __attribute__((aligned(16))) unsigned char lds_raw[];
    LAS unsigned char* lds = (LAS unsigned char*)lds_raw;
    cg::grid_group grid = cg::this_grid();
    const kargp_t karg = (kargp_t)__builtin_amdgcn_kernarg_segment_ptr();
    const int ph_lo = args.ph_lo, ph_hi = args.ph_hi;
    volatile LAS unsigned* MISC = (volatile LAS unsigned*)(lds + LDS_BYTES - 256);
    if (threadIdx.x < 64) MISC[threadIdx.x] = 0u;
    __syncthreads();
    const XcdBarrier xb = xcd_barrier_post((unsigned*)(args.ws + WS_BAR), MISC + 8);

    for (int phx = ph_lo; phx < ph_hi; ++phx) {
        const int ph = (phx < 36) ? phx : (PROBE_MAP(phx - 36));
        int tid = threadIdx.x; asm volatile("" : "+v"(tid));
        const int lane = tid & 63, wave = __builtin_amdgcn_readfirstlane(tid >> 6);
        int G = gridDim.x, bx = blockIdx.x; asm volatile("" : "+s"(G), "+s"(bx));
        const int gw = bx * 8 + wave, NGW = G * 8, gt = bx * 512 + tid, NGT = G * 512;
        LAS float* scr = (LAS float*)(lds + wave * 16640);
        kargp_t kp = karg; asm volatile("" : "+s"(kp));
        float* hout = *(float* const __attribute__((address_space(4)))*)(kp + 8 * 33); unsigned char* ws = *(unsigned char* const __attribute__((address_space(4)))*)(kp + 8 * 34);
        unsigned char* ar = ws + WS_AR; const float* x_in = IN(0);
        bf16_t* HB = (bf16_t*)(ws + WS_HB); float* Yb = (float*)(ws + WS_Y);
        float* tab = (float*)(ws + WS_TAB); float* bt2 = (float*)(ws + WS_BT); float* stats = (float*)(ws + WS_STATS);
        int layer, kind, sub;
        if (ph == 0 || ph >= 100) { layer = -1; kind = -1; sub = 0; }
        else if (ph < 10) { layer = 0; kind = 0; sub = ph - 1; }
        else if (ph < 20) { layer = 1; kind = 1; sub = ph - 10; }
        else if (ph < 27) { layer = 2; kind = 2; sub = ph - 20; }
        else { layer = 3; kind = 0; sub = ph - 27; }
        const int nsub = (kind == 0) ? 9 : (kind == 1) ? 10 : 7;
        const int tail = sub - (nsub - 4);
        const bool nosync = (kind == 0 && sub == 2) || (kind == 1 && sub == 1);
        if (phx > ph_lo && !nosync) { if (phx == 1) grid.sync(); else xcd_barrier(xb); }
        const float* hres = (layer <= 0) ? x_in : Yb;
        const float* rg = (layer <= 0) ? nullptr : IN(29) + (size_t)((layer - 1) * 2 + 1) * 2048; const float* rb = (layer <= 0) ? nullptr : IN(30) + (size_t)((layer - 1) * 2 + 1) * 2048;
        pg8::Gemm g0{}; EpiP e0{}; int ng = 0;

        if (ph >= 100) {
        } else if (ph == 0) {
            for (int job = 0; job < 18; ++job) {
                const float* W = nullptr; int Ks = 0, Ns = 0, ldwt = 0, Nd = 0, kd = 0; const float* rs = nullptr; bf16_t* WT = nullptr;
                if (job < 8) { const int j = job >> 2, w = job & 3; unsigned char* base = ws + WS_MLA_W + (size_t)j * 20 * MiB;
                    if (w == 0) { W = IN(1) + (size_t)j * 2048 * 1088; Ks = 2048; Ns = 1088; WT = (bf16_t*)base; ldwt = 2048; Nd = 1280; kd = 1; }
                    else if (w == 1) { W = IN(4) + (size_t)j * 512 * 3072; Ks = 512; Ns = 3072; WT = (bf16_t*)(base + 5 * MiB); ldwt = 512; Nd = 3072; kd = 2; rs = IN(2) + j * 512; }
                    else if (w == 2) { W = IN(5) + (size_t)j * 512 * 4096; Ks = 512; Ns = 4096; WT = (bf16_t*)(base + 8 * MiB); ldwt = 512; Nd = 4096; kd = 0; rs = IN(3) + j * 512; }
                    else { W = IN(6) + (size_t)j * 2048 * 2048; Ks = 2048; Ns = 2048; WT = (bf16_t*)(base + 12 * MiB); ldwt = 2048; Nd = 2048; kd = 0; } }
                else if (job < 11) { const int n = job - 8; W = IN(8) + (size_t)n * 2048 * 2048; Ks = 2048; Ns = 2048; WT = (bf16_t*)(ws + WS_RW_W) + (size_t)n * 2048 * 2048; ldwt = 2048; Nd = 2048; }
                else if (job == 11) { W = IN(10); Ks = 2048; Ns = 96; WT = (bf16_t*)(ws + WS_RW_W + 24 * MiB); ldwt = 2048; Nd = 256; }
                else if (job == 12) { W = IN(13); Ks = 2048; Ns = 96; WT = (bf16_t*)(ws + WS_RW_W + 24 * MiB) + (size_t)256 * 2048; ldwt = 2048; Nd = 256; }
                else if (job == 13) { W = IN(15); Ks = 2048; Ns = 256; WT = (bf16_t*)(ws + WS_RW_W + 24 * MiB) + (size_t)512 * 2048; ldwt = 2048; Nd = 256; }
                else if (job == 14) { W = IN(16); Ks = 256; Ns = 2048; WT = (bf16_t*)(ws + WS_RW_W + 27 * MiB) + (size_t)4096 * 256; ldwt = 256; Nd = 2048; }
                else if (job == 15) { W = IN(22); Ks = 2048; Ns = 2048; WT = (bf16_t*)(ws + WS_RW_W + 30 * MiB); ldwt = 2048; Nd = 2048; }
                else if (job == 16) { W = IN(23); Ks = 2048; Ns = 2560; WT = (bf16_t*)(ws + WS_SW_W); ldwt = 2048; Nd = 2560; }
                else { W = IN(26); Ks = 2048; Ns = 2048; WT = (bf16_t*)(ws + WS_SW_W + 10 * MiB); ldwt = 2048; Nd = 2048; }
                transpose_w(W, Ks, Ns, WT, ldwt, Nd, kd, rs, scr, gw, NGW, lane);
            }
            transpose_small(IN(11), (bf16_t*)(ws + WS_RW_W + 27 * MiB), gt, NGT);
            transpose_small(IN(14), (bf16_t*)(ws + WS_RW_W + 27 * MiB) + (size_t)2048 * 256, gt, NGT);
            for (int idx = gt; idx < 8192 * 32; idx += NGT) { const int pos = idx >> 5, i = idx & 31;
                float c, s; rope_cs(pos, i, c, s);
                tab[2 * idx] = c; tab[2 * idx + 1] = s; }
            { const float* rb = IN(28);
            for (int idx = gt; idx < 32 * 128; idx += NGT) { const int hd = idx >> 7, n = idx & 127; int bucket;
                if (n < 16) bucket = n; else { const float nf = (float)n; int lg = 16 + (int)(logf(nf / 16.0f) / 2.0794415416798357f * 16.0f); lg = lg < 31 ? lg : 31; bucket = lg; }
                bt2[idx] = rb[bucket * 32 + hd] * LOG2E; } }
            for (int idx = gt; idx < M * 256; idx += NGT) { const size_t off = (size_t)idx * 8; *(u32x4*)(HB + off) = pack8(*(const f32x4*)(x_in + off), *(const f32x4*)(x_in + off + 4)); }
        } else if (tail == 0 || tail == 3) {
            const float* lg = IN(29) + (size_t)(layer * 2 + (tail == 3 ? 1 : 0)) * 2048; const float* lb = IN(30) + (size_t)(layer * 2 + (tail == 3 ? 1 : 0)) * 2048;
            if (tail == 0) {
                transpose_w(IN(31) + (size_t)layer * 2048 * 8192, 2048, 8192, (bf16_t*)(ws + WS_MLPW), 2048, 8192, 0, nullptr, scr, gw, NGW, lane);
                transpose_w(IN(32) + (size_t)layer * 8192 * 2048, 8192, 2048, (bf16_t*)(ws + WS_MLPW + 32 * MiB), 8192, 2048, 0, nullptr, scr, gw, NGW, lane);
            }
            if (layer == 0 && tail == 3) {
                if (G == 256) { for (int k = 0; k < 2; ++k) { const int row = 2048 * (bx & 7) + 1024 * k + ((bx >> 3) * 8 + wave) * 4;
                        ln_mix_rows4(Yb + (size_t)row * 2048, row, lg, lb, IN(7), (bf16_t*)(ar + AR_X6), stats + 2 * (size_t)row, lane); } }
                else for (int row = gw * 4; row < M; row += NGW * 4) ln_mix_rows4(Yb + (size_t)row * 2048, row, lg, lb, IN(7), (bf16_t*)(ar + AR_X6), stats + 2 * (size_t)row, lane);
            } else {
                if (G == 256) { for (int k = 0; k < 2; ++k) { const int row = 2048 * (bx & 7) + 1024 * k + ((bx >> 3) * 8 + wave) * 4;
                        ln_rows4(Yb + (size_t)row * 2048, lg, lb, hout + (size_t)row * 2048, HB + (size_t)row * 2048, stats + 2 * (size_t)row, layer == 3 && tail == 3, lane); } }
                else for (int row = gw * 4; row < M; row += NGW * 4) ln_rows4(Yb + (size_t)row * 2048, lg, lb, hout + (size_t)row * 2048, HB + (size_t)row * 2048, stats + 2 * (size_t)row, layer == 3 && tail == 3, lane);
            }
        } else if (tail == 1) {
            g0 = pg8::Gemm{HB, (const bf16_t*)(ws + WS_MLPW), M, FF, 2048, 2048, 2048, 1 << 20, 0}; e0.mode = EM_RELU2; e0.o0 = (bf16_t*)(ar + AR_HID); e0.ldc = FF; ng = 1;
        } else if (tail == 2) {
            g0 = pg8::Gemm{(const bf16_t*)(ar + AR_HID), (const bf16_t*)(ws + WS_MLPW + 32 * MiB), M, 2048, FF, FF, FF, 1 << 20, 0}; e0.mode = EM_RESID; e0.res = Yb; e0.outf = Yb; e0.f0 = stats; e0.p0 = IN(29) + (size_t)(layer * 2) * 2048; e0.p1 = IN(30) + (size_t)(layer * 2) * 2048; e0.ldc = 2048; ng = 1;
        } else if (kind == 0) {
            const int j = layer == 0 ? 0 : 1; unsigned char* wb = ws + WS_MLA_W + (size_t)j * 20 * MiB;
            bf16_t* LAT = (bf16_t*)(ar + AR_LAT); float* PART = (float*)(ar + AR_PART); bf16_t* KROPE = (bf16_t*)(ar + AR_KROPE); bf16_t* Qb = (bf16_t*)(ar + AR_Q);
            bf16_t* KN = (bf16_t*)(ar + AR_KN); bf16_t* VT = (bf16_t*)(ar + AR_VT); bf16_t* Ob = (bf16_t*)(ar + AR_O);
            if (sub == 0) { g0 = pg8::Gemm{HB, (const bf16_t*)wb, M, 1280, 2048, 2048, 2048, 1 << 20, 0}; e0.mode = EM_MLA_IN; e0.o0 = LAT; e0.f0 = PART; e0.o1 = KROPE; e0.tab = tab; ng = 1; }
            else if (sub == 1) { g0 = pg8::Gemm{LAT, (const bf16_t*)(wb + 5 * MiB), M, 3072, 512, 1024, 512, 1 << 20, 0}; e0.mode = EM_MLA_Q; e0.o0 = Qb; e0.f0 = PART; e0.tab = tab; ng = 1; }
            else if (sub == 2) { g0 = pg8::Gemm{LAT + 512, (const bf16_t*)(wb + 8 * MiB), M, 4096, 512, 1024, 512, 1 << 20, 0}; e0.mode = EM_MLA_KV; e0.o0 = KN; e0.o1 = VT; e0.f0 = PART; ng = 1; }
            else if (sub == 3) {
#ifndef NO_MLA
                mla_attn_phase(lds, Qb, KN, KROPE, VT, Ob, G, bx, tid);
#endif
            }
            else { g0 = pg8::Gemm{Ob, (const bf16_t*)(wb + 12 * MiB), M, 2048, 2048, 2048, 2048, 1 << 20, 0}; e0.mode = EM_RESID; e0.res = hres; e0.outf = Yb; e0.f0 = stats; e0.p0 = rg; e0.p1 = rb; e0.ldc = 2048; ng = 1; }
        } else if (kind == 1) {
            bf16_t* X6 = (bf16_t*)(ar + AR_X6); bf16_t* RKV = (bf16_t*)(ar + AR_RKV); bf16_t* LH = (bf16_t*)(ar + AR_LH);
            float* DEC = (float*)(ar + AR_DEC); float* AF = (float*)(ar + AR_AF); bf16_t* GB = (bf16_t*)(ar + AR_GB); bf16_t* YG = (bf16_t*)(ar + AR_YG);
            unsigned char* wb = ws + WS_RW_W;
            if (sub == 0) { g0 = pg8::Gemm{X6, (const bf16_t*)wb, M, 6144, 2048, 2048, 2048, 8, SLOT}; e0.mode = EM_SPLIT; e0.o0 = RKV; ng = 1; }
            else if (sub == 1) { g0 = pg8::Gemm{X6 + 3 * (SLOT / 2), (const bf16_t*)(wb + 24 * MiB), M, 768, 2048, 2048, 2048, 1, SLOT}; e0.mode = EM_LORA_DOWN; e0.o0 = LH; ng = 1; }
            else if (sub == 2) { g0 = pg8::Gemm{LH, (const bf16_t*)(wb + 27 * MiB), M, 6144, 256, 768, 256, 8, 512}; e0.mode = EM_LORA_UP; e0.f0 = DEC; e0.f1 = AF; e0.o0 = GB; e0.p0 = IN(9); e0.p1 = IN(12); ng = 1; }
            else if (sub == 3) {
#ifndef NO_SCAN
                if (G == 256) rwkv_scan_phase(lds, RKV, DEC, AF, IN(17), IN(18), IN(19), (float*)(ar + AR_BON), hout, bx, tid);
#endif
            }
            else if (sub == 4) { rwkv_gn_phase(hout, RKV + 2 * (SLOT / 2), (const float*)(ar + AR_BON), GB, IN(20), IN(21), YG, gw, NGW, lane); }
            else { g0 = pg8::Gemm{YG, (const bf16_t*)(wb + 30 * MiB), M, 2048, 2048, 2048, 2048, 1 << 20, 0}; e0.mode = EM_RESID; e0.res = hres; e0.outf = Yb; e0.f0 = stats; e0.p0 = rg; e0.p1 = rb; e0.ldc = 2048; ng = 1; }
        } else {
            bf16_t* SQ = (bf16_t*)(ar + AR_SQ); bf16_t* SK = (bf16_t*)(ar + AR_SK); bf16_t* SVT = (bf16_t*)(ar + AR_SVT); bf16_t* SO = (bf16_t*)(ar + AR_SO);
            unsigned char* wb = ws + WS_SW_W;
            if (sub == 0) { g0 = pg8::Gemm{HB, (const bf16_t*)wb, M, 2560, 2048, 2048, 2048, 1 << 20, 0}; e0.mode = EM_SWA_QKV; e0.o0 = SQ; e0.o1 = SK; e0.o2 = SVT; e0.bias = IN(24); ng = 1; }
            else if (sub == 1) {
#ifndef NO_SWA
                swa_attn_phase(lds, SQ, SK, SVT, SO, bt2, IN(25), G, bx, tid);
#endif
            }
            else { g0 = pg8::Gemm{SO, (const bf16_t*)(wb + 10 * MiB), M, 2048, 2048, 2048, 2048, 1 << 20, 0}; e0.mode = EM_RESID; e0.res = hres; e0.outf = Yb; e0.f0 = stats; e0.p0 = rg; e0.p1 = rb; e0.bias = IN(27); e0.ldc = 2048; ng = 1; }
        }
#ifndef NO_GEMM
        if (ng) { pg8::StaticOrder S; S.init(g0.M, g0.N, G, bx); pg8::gemm_phase<EpiP>(lds, g0, S, e0, tid); }
#endif
    }
}

extern "C" void kernel_launch(void* const* d_in, const int* in_sizes, int n_in, void* d_out, int out_size, void* d_ws, size_t ws_size, hipStream_t stream) {
    static int grid = 0;
    if (grid == 0) {
        if (n_in != 33 || out_size != M * DM || ws_size < WS_END) { fprintf(stderr, "kernel_launch: unexpected problem (n_in %d, out %d, ws %zu < %zu)\n", n_in, out_size, ws_size, (size_t)WS_END); grid = -1; return; }
        int dev = 0, cus = 0, per_cu = 0;
        hipGetDevice(&dev); hipDeviceGetAttribute(&cus, hipDeviceAttributeMultiprocessorCount, dev);
        if (hipFuncSetAttribute((const void*)hybrid_fwd, hipFuncAttributeMaxDynamicSharedMemorySize, LDS_BYTES) != hipSuccess) { fprintf(stderr, "kernel_launch: hipFuncSetAttribute failed\n"); grid = -1; return; }
        if (hipOccupancyMaxActiveBlocksPerMultiprocessor(&per_cu, (const void*)hybrid_fwd, 512, LDS_BYTES) != hipSuccess || per_cu < 1) { fprintf(stderr, "kernel_launch: occupancy query says %d\n", per_cu); per_cu = 1; }
        (void)hipGetLastError();
        grid = cus;
        fprintf(stderr, "kernel_launch: grid %d (cus %d, per_cu %d)\n", grid, cus, per_cu);
    }
    if (grid < 0) return;
    Args a{};
    for (int i = 0; i < 33; ++i) a.in[i] = (const float*)d_in[i];
    a.out = (float*)d_out; a.ws = (unsigned char*)d_ws;
#ifndef MK_PER_PHASE
    a.ph_lo = 0; a.ph_hi = N_PHASES;
    if (hipMemsetAsync((char*)d_ws + WS_BAR, 0, WS_BAR_BYTES, stream) != hipSuccess) { fprintf(stderr, "kernel_launch: memset of the barrier words failed\n"); return; }
    void* kargs[] = {&a};
    hipError_t e = hipLaunchCooperativeKernel((const void*)hybrid_fwd, dim3(grid), dim3(512), kargs, LDS_BYTES, stream);
    if (e != hipSuccess) fprintf(stderr, "cooperative launch failed: %s (grid %d)\n", hipGetErrorString(e), grid);
#else
    for (int ph = 0; ph < N_PHASES; ++ph) { a.ph_lo = ph; a.ph_hi = ph + 1; hipLaunchKernelGGL(hybrid_fwd, dim3(grid), dim3(512), LDS_BYTES, stream, a); }
#endif
}
```

```cpp
#include <hip/hip_runtime.h>
#include <hip/hip_cooperative_groups.h>
#include <cstdio>
#include <cstdint>
namespace cg = cooperative_groups;

#define GAS __attribute__((address_space(1)))
#define LAS __attribute__((address_space(3)))
typedef unsigned short bf16_t;
typedef short bf16x8 __attribute__((ext_vector_type(8)));
typedef float f32x4 __attribute__((ext_vector_type(4)));
typedef float f32x2 __attribute__((ext_vector_type(2)));
typedef float f32x16 __attribute__((ext_vector_type(16)));
typedef unsigned u32x4 __attribute__((ext_vector_type(4)));
typedef unsigned u32x2 __attribute__((ext_vector_type(2)));

constexpr int M = 16384, DM = 2048, SEQ = 8192, FF = 8192;
constexpr float ALPHA = 1.6817928305074290f;
constexpr float LOG2E = 1.4426950408889634f;
constexpr size_t MiB = 1u << 20;
constexpr size_t WS_TAB = 0;
constexpr size_t WS_BT = 2 * MiB;
constexpr size_t WS_STATS = 3 * MiB;
constexpr size_t WS_BAR = 3 * MiB + 512 * 1024;
constexpr size_t WS_BAR_BYTES = 16384;
constexpr size_t WS_MLA_W = 4 * MiB;
constexpr size_t WS_RW_W = 44 * MiB;
constexpr size_t WS_SW_W = 82 * MiB;
constexpr size_t WS_MLPW = 100 * MiB;
constexpr size_t WS_HB = 164 * MiB;
constexpr size_t WS_Y = 228 * MiB;
constexpr size_t WS_AR = 356 * MiB;
constexpr size_t WS_END = WS_AR + 602 * MiB;
constexpr size_t AR_HID = 0;
constexpr size_t AR_LAT = 0, AR_PART = 32 * MiB, AR_KROPE = 33 * MiB, AR_Q = 36 * MiB, AR_KN = 132 * MiB, AR_VT = 196 * MiB, AR_O = 260 * MiB;
constexpr size_t AR_BON = 600 * MiB;
constexpr size_t AR_X6 = 0, AR_RKV = 384 * MiB, AR_LH = 576 * MiB, AR_DEC = 0, AR_AF = 128 * MiB, AR_GB = 256 * MiB, AR_YG = 320 * MiB;
constexpr size_t AR_SQ = 0, AR_SK = 64 * MiB, AR_SVT = 72 * MiB, AR_SO = 80 * MiB;
constexpr size_t SLOT = (size_t)M * DM * 2;

constexpr int LDS_BYTES = 131072 + 4096;

__device__ __forceinline__ unsigned cvt_pk_bf16(float lo, float hi) { unsigned r; asm volatile("v_cvt_pk_bf16_f32 %0, %1, %2" : "=v"(r) : "v"(lo), "v"(hi)); return r; }
__device__ __forceinline__ float bf2f(unsigned short b) { return __builtin_bit_cast(float, (unsigned)b << 16); }
__device__ __forceinline__ float bflo(unsigned w) { return __builtin_bit_cast(float, w << 16); }
__device__ __forceinline__ float bfhi(unsigned w) { return __builtin_bit_cast(float, w & 0xffff0000u); }
__device__ __forceinline__ u32x4 pack8(f32x4 a, f32x4 b) { u32x4 w; w.x = cvt_pk_bf16(a[0], a[1]); w.y = cvt_pk_bf16(a[2], a[3]); w.z = cvt_pk_bf16(b[0], b[1]); w.w = cvt_pk_bf16(b[2], b[3]); return w; }
__device__ __forceinline__ float wave_sum(float v) {
#pragma unroll
    for (int o = 1; o < 64; o <<= 1) v += __shfl_xor(v, o);
    return v;
}
template <int CTRL> __device__ __forceinline__ float dpp_f(float x) { return __builtin_bit_cast(float, __builtin_amdgcn_update_dpp(0, __builtin_bit_cast(int, x), CTRL, 0xF, 0xF, true)); }
__device__ __forceinline__ float sum16(float x) { x += dpp_f<0xB1>(x); x += dpp_f<0x4E>(x); x += dpp_f<0x141>(x); x += dpp_f<0x140>(x); return x; }
__device__ __forceinline__ float sigmoidf_(float x) { return 1.0f / (1.0f + __expf(-x)); }
__device__ __forceinline__ int crow(int r, int hi) { return (r & 3) + 8 * (r >> 2) + 4 * hi; }

namespace pg8 {
constexpr int BM = 256, BK = 64, HALF = 128, HTB = HALF * BK * 2, STAGE_BYTES = 8 * HTB, NXCD = 8, WGM = 4;
__host__ __device__ __forceinline__ int lds_byte(int r, int c) { const int st = (r >> 4) * 2 + (c >> 5), rr = r & 15, cc = c & 31, ob = rr * 64 + cc * 2; return st * 1024 + (ob ^ (((ob >> 9) & 1) << 5)); }
__host__ __device__ __forceinline__ void stage_rc(int b, int& R, int& C) { const int st = b / 1024, sb = b % 1024, swz = sb ^ (((sb >> 9) & 1) << 5); R = (st >> 1) * 16 + swz / 64; C = (st & 1) * 32 + (swz % 64) / 2; }
__host__ __device__ __forceinline__ int perm32(int rho) { const int n = rho >> 4, i = rho & 15; return 8 * (i >> 2) + 4 * n + (i & 3); }

struct Unit { int pm, pn; };
struct Gemm { const bf16_t* A; const bf16_t* Bt; int M, N, K, lda, ldb, a_group; size_t a_stride; };

struct StaticOrder {
    int nM, nN, nwg, G, c;
    __device__ void init(int M_, int N_, int G_, int c_) { nM = M_ / BM; nN = N_ / BM; nwg = nM * nN; G = G_; c = c_; }
    __device__ bool next(int i, Unit& u) const {
        const long L = (long)i * G + c; if (L >= nwg) return false;
        int wgid = (int)L; { const int q = nwg / NXCD, r = nwg % NXCD, xcd = wgid % NXCD, off = wgid / NXCD; wgid = (xcd < r ? xcd * (q + 1) : r * (q + 1) + (xcd - r) * q) + off; }
        const int wgm = (nN >= 16) ? 8 : 4;
        const int nig = wgm * nN, gid = wgid / nig, fm = gid * wgm, gsz = (nM - fm) < wgm ? (nM - fm) : wgm;
        u.pm = fm + ((wgid % nig) % gsz); u.pn = (wgid % nig) / gsz; return true;
    }
};

template <class Epi>
__device__ __forceinline__ void gemm_phase(LAS unsigned char* lds, const Gemm g, const StaticOrder& S, const Epi& E, const int tid) {
    const int wid = __builtin_amdgcn_readfirstlane(tid >> 6), lane = tid & 63, wr = wid >> 2, wc = wid & 3, fr = lane & 15, fq = lane >> 4;
    const int K = g.K, nt = K / BK;
    unsigned voffA[2], voffB[2];
#pragma unroll
    for (int i = 0; i < 2; ++i) { int R, C; stage_rc(tid * 16 + i * 8192, R, C); const int Rb = (R & ~31) + perm32(R & 31);
        voffA[i] = (unsigned)(R * g.lda + C) * 2u; voffB[i] = (unsigned)(Rb * g.ldb + C) * 2u; }
    const size_t kstep = (size_t)(BK * 2);
    const size_t hstepA = (size_t)HALF * g.lda * 2, hstepB = (size_t)HALF * g.ldb * 2;
    const size_t tstepA = 2 * hstepA, tstepB = 2 * hstepB;
    const unsigned ldsw = (unsigned)wid * 1024u;
    const int aoff = lds_byte(wr * 64 + fr, fq * 8), boff = lds_byte(wc * 32 + fr, fq * 8);
#define PG8_SA(b, h) (((b) * 2 + (h)) * HTB)
#define PG8_SB(b, h) ((4 + (b) * 2 + (h)) * HTB)
#define PG8_STAGE(bufoff, gbase, voff) do { _Pragma("unroll") for (int _i = 0; _i < 2; ++_i) \
        __builtin_amdgcn_global_load_lds((const unsigned*)((const char*)(gbase) + (voff)[_i]), (LAS unsigned*)(lds + (bufoff) + ldsw + _i * 8192), 16, 0, 0); } while (0)
#define PG8_LDA(dst, b, h) do { _Pragma("unroll") for (int m = 0; m < 4; ++m) _Pragma("unroll") for (int k = 0; k < 2; ++k) dst[m][k] = *(const LAS bf16x8*)(lds + PG8_SA(b, h) + aoff + m * 2048 + k * 1024); } while (0)
#define PG8_LDB(dst, b, h) do { _Pragma("unroll") for (int n = 0; n < 2; ++n) _Pragma("unroll") for (int k = 0; k < 2; ++k) dst[n][k] = *(const LAS bf16x8*)(lds + PG8_SB(b, h) + boff + n * 2048 + k * 1024); } while (0)
#define PG8_MMA(ai, bj, At, Bt) do { __builtin_amdgcn_s_setprio(1); _Pragma("unroll") for (int m = 0; m < 4; ++m) _Pragma("unroll") for (int n = 0; n < 2; ++n) _Pragma("unroll") for (int k = 0; k < 2; ++k) \
        acc[ai][bj][m][n] = __builtin_amdgcn_mfma_f32_16x16x32_bf16(Bt[n][k], At[m][k], acc[ai][bj][m][n], 0, 0, 0); __builtin_amdgcn_s_setprio(0); } while (0)
#define PG8_WAIT_V(n) asm volatile("s_waitcnt vmcnt(" #n ")" ::: "memory")
#define PG8_WAIT_L(n) asm volatile("s_waitcnt lgkmcnt(" #n ")" ::: "memory")
#define PG8_BAR __builtin_amdgcn_s_barrier()
#define PG8_SCHED __builtin_amdgcn_sched_barrier(0)
    Unit cur, nxt; int ui = 0;
    if (!S.next(0, cur)) return;
    f32x4 acc[2][2][4][2];
#pragma unroll
    for (int a = 0; a < 2; ++a)
#pragma unroll
        for (int b = 0; b < 2; ++b)
#pragma unroll
            for (int m = 0; m < 4; ++m)
#pragma unroll
                for (int n = 0; n < 2; ++n) acc[a][b][m][n] = (f32x4){0.f, 0.f, 0.f, 0.f};
    bf16x8 At[4][2], B0[2][2], B1[2][2];
    const char* cA = (const char*)g.A + (size_t)cur.pm * tstepA + (size_t)(cur.pn / g.a_group) * g.a_stride; const char* cB = (const char*)g.Bt + (size_t)cur.pn * tstepB;
    PG8_STAGE(PG8_SB(0, 0), cB, voffB); PG8_STAGE(PG8_SB(0, 1), cB + hstepB, voffB); PG8_STAGE(PG8_SA(0, 0), cA, voffA); PG8_STAGE(PG8_SA(0, 1), cA + hstepA, voffA);
    if (wr == 1) PG8_BAR;
    PG8_WAIT_V(2); PG8_BAR;
    PG8_STAGE(PG8_SB(1, 0), cB + kstep, voffB); PG8_STAGE(PG8_SA(1, 0), cA + kstep, voffA); PG8_STAGE(PG8_SB(1, 1), cB + hstepB + kstep, voffB);
    PG8_WAIT_V(6); PG8_BAR;
    for (;;) {
        const bool has_next = S.next(ui + 1, nxt);
        const char* nA = has_next ? (const char*)g.A + (size_t)nxt.pm * tstepA + (size_t)(nxt.pn / g.a_group) * g.a_stride : cA; const char* nB = has_next ? (const char*)g.Bt + (size_t)nxt.pn * tstepB : cB;
        for (int t = 0; t < nt; t += 2) {
            const bool last = (t == nt - 2);
            const char* a1 = cA + (size_t)(t + 1) * kstep;
            const char* a2 = last ? nA : cA + (size_t)(t + 2) * kstep; const char* b2 = last ? nB : cB + (size_t)(t + 2) * kstep;
            const char* a3 = a2 + kstep; const char* b3 = b2 + kstep;
            PG8_LDB(B0, 0, 0); PG8_LDB(B1, 0, 1); PG8_SCHED; PG8_LDA(At, 0, 0); PG8_STAGE(PG8_SA(1, 1), a1 + hstepA, voffA);
            PG8_WAIT_V(8); PG8_WAIT_L(0); PG8_BAR; PG8_MMA(0, 0, At, B0); PG8_MMA(0, 1, At, B1); PG8_BAR; PG8_SCHED;
            PG8_LDA(At, 0, 1); PG8_STAGE(PG8_SB(0, 0), b2, voffB); PG8_STAGE(PG8_SB(0, 1), b2 + hstepB, voffB); PG8_STAGE(PG8_SA(0, 0), a2, voffA);
            PG8_WAIT_V(8); PG8_WAIT_L(0); PG8_BAR; PG8_MMA(1, 0, At, B0); PG8_MMA(1, 1, At, B1); PG8_BAR; PG8_SCHED;
            PG8_LDB(B0, 1, 0); PG8_LDB(B1, 1, 1); PG8_SCHED; PG8_LDA(At, 1, 0); PG8_STAGE(PG8_SA(0, 1), a2 + hstepA, voffA);
            PG8_WAIT_V(8); PG8_WAIT_L(0); PG8_BAR; PG8_MMA(0, 0, At, B0); PG8_MMA(0, 1, At, B1); PG8_BAR; PG8_SCHED;
            PG8_LDA(At, 1, 1); PG8_STAGE(PG8_SB(1, 0), b3, voffB); PG8_STAGE(PG8_SB(1, 1), b3 + hstepB, voffB); PG8_STAGE(PG8_SA(1, 0), a3, voffA);
            PG8_WAIT_V(8); PG8_WAIT_L(0); PG8_BAR; PG8_MMA(1, 0, At, B0); PG8_MMA(1, 1, At, B1); PG8_BAR; PG8_SCHED;
        }
        if (wr == 0) PG8_BAR;
        E(acc, cur, wr, wc, fr, fq);
        if (!has_next) break;
#pragma unroll
        for (int a = 0; a < 2; ++a)
#pragma unroll
            for (int b = 0; b < 2; ++b)
#pragma unroll
                for (int m = 0; m < 4; ++m)
#pragma unroll
                    for (int n = 0; n < 2; ++n) acc[a][b][m][n] = (f32x4){0.f, 0.f, 0.f, 0.f};
        cur = nxt; cA = nA; cB = nB; ++ui;
        if (wr == 1) PG8_BAR;
    }
    PG8_WAIT_V(0);
    PG8_BAR;
#undef PG8_SA
#undef PG8_SB
#undef PG8_STAGE
#undef PG8_LDA
#undef PG8_LDB
#undef PG8_MMA
#undef PG8_WAIT_V
#undef PG8_WAIT_L
#undef PG8_BAR
#undef PG8_SCHED
}
}

enum EpiMode { EM_RESID = 0, EM_RELU2, EM_SPLIT, EM_LORA_DOWN, EM_LORA_UP, EM_SWA_QKV, EM_MLA_IN, EM_MLA_Q, EM_MLA_KV };
struct EpiP {
    int mode;
    const float* res; const float* bias; float* outf;
    bf16_t* o0; bf16_t* o1; bf16_t* o2;
    float* f0; float* f1;
    const float* p0; const float* p1;
    const float* tab;
    int ldc;
    __device__ __forceinline__ void operator()(const f32x4 (&acc)[2][2][4][2], const pg8::Unit& u, int wr, int wc, int fr, int fq) const {
        const int row0 = u.pm * 256 + wr * 64 + fr, colb = u.pn * 256 + wc * 32 + 8 * fq;
#define EPI_BEGIN _Pragma("unroll") for (int ai = 0; ai < 2; ++ai) _Pragma("unroll") for (int m = 0; m < 4; ++m) { const int row = row0 + ai * 128 + m * 16; \
        _Pragma("unroll") for (int bj = 0; bj < 2; ++bj) { const int col = colb + bj * 128; f32x4 v0 = acc[ai][bj][m][0], v1 = acc[ai][bj][m][1];
#define EPI_END } asm volatile("" ::: "memory"); }
        if (mode == EM_RESID) {
            EPI_BEGIN { const size_t off = (size_t)row * ldc + col; f32x4 r0 = *(const f32x4*)(res + off), r1 = *(const f32x4*)(res + off + 4);
                if (p0) { const f32x2 ms = *(const f32x2*)(f0 + 2 * (size_t)row); const f32x4 g0 = *(const f32x4*)(p0 + col), g1 = *(const f32x4*)(p0 + col + 4), b0 = *(const f32x4*)(p1 + col), b1 = *(const f32x4*)(p1 + col + 4);
                    r0 = (r0 - ms[0]) * ms[1] * g0 + b0; r1 = (r1 - ms[0]) * ms[1] * g1 + b1; }
                if (bias) { v0 += *(const f32x4*)(bias + col); v1 += *(const f32x4*)(bias + col + 4); }
                *(f32x4*)(outf + off) = r0 * ALPHA + v0; *(f32x4*)(outf + off + 4) = r1 * ALPHA + v1; } EPI_END
        } else if (mode == EM_RELU2) {
            EPI_BEGIN { const f32x4 z = {0.f, 0.f, 0.f, 0.f}; v0 = __builtin_elementwise_max(v0, z); v1 = __builtin_elementwise_max(v1, z); v0 = v0 * v0; v1 = v1 * v1;
                *(u32x4*)(o0 + (size_t)row * ldc + col) = pack8(v0, v1); } EPI_END
        } else if (mode == EM_SPLIT) {
            EPI_BEGIN { const int s = col >> 11, c = col & 2047; *(u32x4*)(o0 + (size_t)s * (SLOT / 2) + (size_t)row * 2048 + c) = pack8(v0, v1); } EPI_END
        } else if (mode == EM_LORA_DOWN) {
            const int pn = u.pn;
            EPI_BEGIN {
                if (pn == 0) {
#pragma unroll
                    for (int e = 0; e < 4; ++e) { v0[e] = 1.0f - 2.0f / (1.0f + __expf(2.0f * v0[e])); v1[e] = 1.0f - 2.0f / (1.0f + __expf(2.0f * v1[e])); }
                } else if (pn == 2) {
#pragma unroll
                    for (int e = 0; e < 4; ++e) { v0[e] = sigmoidf_(v0[e]); v1[e] = sigmoidf_(v1[e]); }
                }
                *(u32x4*)(o0 + (size_t)row * 768 + col) = pack8(v0, v1); } EPI_END
        } else if (mode == EM_LORA_UP) {
            const int grp = u.pn >> 3;
            EPI_BEGIN { const int c = col & 2047; const size_t off = (size_t)row * 2048 + c;
                if (grp == 0) { const f32x4 b0 = *(const f32x4*)(p0 + c), b1 = *(const f32x4*)(p0 + c + 4);
#pragma unroll
                    for (int e = 0; e < 4; ++e) { v0[e] = __expf(-0.6065306597126334f * sigmoidf_(v0[e] + b0[e])); v1[e] = __expf(-0.6065306597126334f * sigmoidf_(v1[e] + b1[e])); }
                    *(f32x4*)(f0 + off) = v0; *(f32x4*)(f0 + off + 4) = v1;
                } else if (grp == 1) { const f32x4 b0 = *(const f32x4*)(p1 + c), b1 = *(const f32x4*)(p1 + c + 4);
#pragma unroll
                    for (int e = 0; e < 4; ++e) { v0[e] = sigmoidf_(v0[e] + b0[e]); v1[e] = sigmoidf_(v1[e] + b1[e]); }
                    *(f32x4*)(f1 + off) = v0; *(f32x4*)(f1 + off + 4) = v1;
                } else { *(u32x4*)(o0 + off) = pack8(v0, v1); } } EPI_END
        } else if (mode == EM_SWA_QKV) {
            const float qs = 0.125f * LOG2E;
            EPI_BEGIN { v0 += *(const f32x4*)(bias + col); v1 += *(const f32x4*)(bias + col + 4);
                if (col < 2048) { *(u32x4*)(o0 + (size_t)row * 2048 + col) = pack8(v0 * qs, v1 * qs); }
                else if (col < 2304) { *(u32x4*)(o1 + (size_t)row * 256 + (col - 2048)) = pack8(v0, v1); }
                else { const int d = col - 2304, b = row >> 13, t = row & 8191; bf16_t* vp = o2 + ((size_t)(b * 256 + d)) * 8192 + t; const u32x4 w = pack8(v0, v1);
                    vp[0] = (bf16_t)(w.x & 0xffff); vp[8192] = (bf16_t)(w.x >> 16); vp[2 * 8192] = (bf16_t)(w.y & 0xffff); vp[3 * 8192] = (bf16_t)(w.y >> 16);
                    vp[4 * 8192] = (bf16_t)(w.z & 0xffff); vp[5 * 8192] = (bf16_t)(w.z >> 16); vp[6 * 8192] = (bf16_t)(w.w & 0xffff); vp[7 * 8192] = (bf16_t)(w.w >> 16); } } EPI_END
        } else if (mode == EM_MLA_IN) {
            const int pn = u.pn;
#pragma unroll
            for (int ai = 0; ai < 2; ++ai)
#pragma unroll
                for (int m = 0; m < 4; ++m) { const int row = row0 + ai * 128 + m * 16;
                    if (pn < 4) { float ss = 0.f;
#pragma unroll
                        for (int bj = 0; bj < 2; ++bj) { const int col = colb + bj * 128; const f32x4 v0 = acc[ai][bj][m][0], v1 = acc[ai][bj][m][1];
                            ss += (v0[0] * v0[0] + v0[1] * v0[1]) + (v0[2] * v0[2] + v0[3] * v0[3]) + (v1[0] * v1[0] + v1[1] * v1[1]) + (v1[2] * v1[2] + v1[3] * v1[3]);
                            *(u32x4*)(o0 + (size_t)row * 1024 + col) = pack8(v0, v1); }
                        ss += __shfl_xor(ss, 16); ss += __shfl_xor(ss, 32);
                        if (fq == 0) f0[(size_t)row * 16 + pn * 4 + wc] = ss;
                    } else if (wc < 2) {
                        const f32x4 v0 = acc[ai][0][m][0], v1 = acc[ai][0][m][1]; const int pos = row & 8191, i0 = 16 * wc + 4 * fq;
                        const f32x4 t0 = *(const f32x4*)(tab + ((size_t)pos * 32 + i0) * 2), t1 = *(const f32x4*)(tab + ((size_t)pos * 32 + i0) * 2 + 4);
                        const float a0 = v0[0] * t0[0] - v0[1] * t0[1], b0 = v0[1] * t0[0] + v0[0] * t0[1];
                        const float a1 = v0[2] * t0[2] - v0[3] * t0[3], b1 = v0[3] * t0[2] + v0[2] * t0[3];
                        const float a2 = v1[0] * t1[0] - v1[1] * t1[1], b2 = v1[1] * t1[0] + v1[0] * t1[1];
                        const float a3 = v1[2] * t1[2] - v1[3] * t1[3], b3 = v1[3] * t1[2] + v1[2] * t1[3];
                        u32x2 wa, wb; wa.x = cvt_pk_bf16(a0, a1); wa.y = cvt_pk_bf16(a2, a3); wb.x = cvt_pk_bf16(b0, b1); wb.y = cvt_pk_bf16(b2, b3);
                        *(u32x2*)(o1 + (size_t)row * 64 + i0) = wa; *(u32x2*)(o1 + (size_t)row * 64 + 32 + i0) = wb; }
                    asm volatile("" ::: "memory");
                }
        } else if (mode == EM_MLA_Q) {
            const int pn = u.pn; const float qsc = 0.07216878364870322f * LOG2E;
#pragma unroll
            for (int ai = 0; ai < 2; ++ai)
#pragma unroll
                for (int m = 0; m < 4; ++m) { const int row = row0 + ai * 128 + m * 16;
                    const f32x4 pa = *(const f32x4*)(f0 + (size_t)row * 16), pb = *(const f32x4*)(f0 + (size_t)row * 16 + 4);
                    const float ssq = ((pa[0] + pa[1]) + (pa[2] + pa[3])) + ((pb[0] + pb[1]) + (pb[2] + pb[3]));
                    const float sc = qsc / sqrtf(ssq * (1.0f / 512.0f) + 1e-6f);
#pragma unroll
                    for (int bj = 0; bj < 2; ++bj) { const int col = colb + bj * 128; const f32x4 v0 = acc[ai][bj][m][0] * sc, v1 = acc[ai][bj][m][1] * sc;
                        if (pn < 8) { const int h = col >> 7, d = col & 127; *(u32x4*)(o0 + (size_t)row * 3072 + h * 192 + d) = pack8(v0, v1); }
                        else { const int j = col - 2048, h = j >> 6, i0 = (j & 63) >> 1, pos = row & 8191;
                            const f32x4 t0 = *(const f32x4*)(tab + ((size_t)pos * 32 + i0) * 2), t1 = *(const f32x4*)(tab + ((size_t)pos * 32 + i0) * 2 + 4);
                            const float a0 = v0[0] * t0[0] - v0[1] * t0[1], b0 = v0[1] * t0[0] + v0[0] * t0[1];
                            const float a1 = v0[2] * t0[2] - v0[3] * t0[3], b1 = v0[3] * t0[2] + v0[2] * t0[3];
                            const float a2 = v1[0] * t1[0] - v1[1] * t1[1], b2 = v1[1] * t1[0] + v1[0] * t1[1];
                            const float a3 = v1[2] * t1[2] - v1[3] * t1[3], b3 = v1[3] * t1[2] + v1[2] * t1[3];
                            u32x2 wa, wb; wa.x = cvt_pk_bf16(a0, a1); wa.y = cvt_pk_bf16(a2, a3); wb.x = cvt_pk_bf16(b0, b1); wb.y = cvt_pk_bf16(b2, b3);
                            bf16_t* qp = o0 + (size_t)row * 3072 + h * 192 + 128 + i0; *(u32x2*)qp = wa; *(u32x2*)(qp + 32) = wb; } }
                    asm volatile("" ::: "memory");
                }
        } else {
            const int h = u.pn;
#pragma unroll
            for (int ai = 0; ai < 2; ++ai)
#pragma unroll
                for (int m = 0; m < 4; ++m) { const int row = row0 + ai * 128 + m * 16;
                    const f32x4 pa = *(const f32x4*)(f0 + (size_t)row * 16 + 8), pb = *(const f32x4*)(f0 + (size_t)row * 16 + 12);
                    const float ssq = ((pa[0] + pa[1]) + (pa[2] + pa[3])) + ((pb[0] + pb[1]) + (pb[2] + pb[3]));
                    const float sc = 1.0f / sqrtf(ssq * (1.0f / 512.0f) + 1e-6f);
                    { const f32x4 v0 = acc[ai][0][m][0] * sc, v1 = acc[ai][0][m][1] * sc; *(u32x4*)(o0 + (size_t)row * 2048 + h * 128 + wc * 32 + 8 * fq) = pack8(v0, v1); }
                    { const f32x4 v0 = acc[ai][1][m][0] * sc, v1 = acc[ai][1][m][1] * sc; const int b = row >> 13, t = row & 8191, dv = wc * 32 + 8 * fq;
                        bf16_t* vp = o1 + ((size_t)((b * 16 + h) * 128 + dv)) * 8192 + t; const u32x4 w = pack8(v0, v1);
                        vp[0] = (bf16_t)(w.x & 0xffff); vp[8192] = (bf16_t)(w.x >> 16); vp[2 * 8192] = (bf16_t)(w.y & 0xffff); vp[3 * 8192] = (bf16_t)(w.y >> 16);
                        vp[4 * 8192] = (bf16_t)(w.z & 0xffff); vp[5 * 8192] = (bf16_t)(w.z >> 16); vp[6 * 8192] = (bf16_t)(w.w & 0xffff); vp[7 * 8192] = (bf16_t)(w.w >> 16); }
                    asm volatile("" ::: "memory");
                }
        }
#undef EPI_BEGIN
#undef EPI_END
    }
};

__device__ __forceinline__ int colmap(int kind, int n, int Nsrc) {
    if (kind == 1) { if (n < 1024) return n; if (n >= 1088) return -1; const int j = n - 1024; return 1024 + (j >> 1) + 32 * (j & 1); }
    if (kind == 2) { if (n < 2048) return (n >> 7) * 192 + (n & 127); const int j = n - 2048, h = j >> 6, jj = j & 63; return h * 192 + 128 + (jj >> 1) + 32 * (jj & 1); }
    return n < Nsrc ? n : -1;
}
__device__ __forceinline__ void transpose_w(const float* W, int Ksrc, int Nsrc, bf16_t* WT, int ldwt, int Ndst, int kind, const float* rscale, LAS float* scr, int gw, int NGW, int lane) {
    const int nblk = Ndst / 64, nitems = (Ksrc / 64) * nblk;
    const int nl = (lane & 15) * 4, kr = lane >> 4, c = lane & 7;
    if (kind == 0 && Ndst <= Nsrc) {
        f32x4 cur[16], nxt[16];
        int item = gw;
        if (item < nitems) { const int k0 = 64 * (item / nblk), n0 = 64 * (item % nblk);
#pragma unroll
            for (int i = 0; i < 16; ++i) cur[i] = *(const f32x4*)(W + (size_t)(k0 + 4 * i + kr) * Nsrc + n0 + nl); }
        for (; item < nitems; item += NGW) {
            const int k0 = 64 * (item / nblk), n0 = 64 * (item % nblk); const int nit = item + NGW;
            if (nit < nitems) { const int k1 = 64 * (nit / nblk), n1 = 64 * (nit % nblk);
#pragma unroll
                for (int i = 0; i < 16; ++i) nxt[i] = *(const f32x4*)(W + (size_t)(k1 + 4 * i + kr) * Nsrc + n1 + nl); }
#pragma unroll
            for (int i = 0; i < 16; ++i) { const int kk = 4 * i + kr; f32x4 v = cur[i]; if (rscale) v = v * rscale[k0 + kk];
                LAS float* d = scr + kk * 65 + nl; d[0] = v[0]; d[1] = v[1]; d[2] = v[2]; d[3] = v[3]; }
            asm volatile("s_waitcnt lgkmcnt(0)" ::: "memory");
#pragma unroll
            for (int j = 0; j < 8; ++j) { const int n = (lane >> 3) + 8 * j; const LAS float* sp = scr + (8 * c) * 65 + n;
                u32x4 o; o.x = cvt_pk_bf16(sp[0 * 65], sp[1 * 65]); o.y = cvt_pk_bf16(sp[2 * 65], sp[3 * 65]); o.z = cvt_pk_bf16(sp[4 * 65], sp[5 * 65]); o.w = cvt_pk_bf16(sp[6 * 65], sp[7 * 65]);
                *(u32x4*)(WT + (size_t)(n0 + n) * ldwt + k0 + 8 * c) = o; }
            asm volatile("s_waitcnt lgkmcnt(0)" ::: "memory");
#pragma unroll
            for (int i = 0; i < 16; ++i) cur[i] = nxt[i];
        }
        return;
    }
    for (int item = gw; item < nitems; item += NGW) {
        const int kb = item / nblk, nb = item % nblk, k0 = 64 * kb, n0 = 64 * nb;
        if (kind == 0 && n0 + 64 <= Nsrc) {
#pragma unroll 4
            for (int i = 0; i < 16; ++i) { const int kk = 4 * i + kr; f32x4 v = *(const f32x4*)(W + (size_t)(k0 + kk) * Nsrc + n0 + nl); if (rscale) v = v * rscale[k0 + kk];
                LAS float* d = scr + kk * 65 + nl; d[0] = v[0]; d[1] = v[1]; d[2] = v[2]; d[3] = v[3]; }
        } else {
            int src[4];
#pragma unroll
            for (int e = 0; e < 4; ++e) src[e] = colmap(kind, n0 + nl + e, Nsrc);
#pragma unroll 4
            for (int i = 0; i < 16; ++i) { const int kk = 4 * i + kr; const float rs = rscale ? rscale[k0 + kk] : 1.0f; LAS float* d = scr + kk * 65 + nl;
#pragma unroll
                for (int e = 0; e < 4; ++e) d[e] = (src[e] >= 0) ? W[(size_t)(k0 + kk) * Nsrc + src[e]] * rs : 0.f; }
        }
        asm volatile("s_waitcnt lgkmcnt(0)" ::: "memory");
#pragma unroll
        for (int j = 0; j < 8; ++j) { const int n = (lane >> 3) + 8 * j; const LAS float* sp = scr + (8 * c) * 65 + n;
            u32x4 o; o.x = cvt_pk_bf16(sp[0 * 65], sp[1 * 65]); o.y = cvt_pk_bf16(sp[2 * 65], sp[3 * 65]); o.z = cvt_pk_bf16(sp[4 * 65], sp[5 * 65]); o.w = cvt_pk_bf16(sp[6 * 65], sp[7 * 65]);
            *(u32x4*)(WT + (size_t)(n0 + n) * ldwt + k0 + 8 * c) = o; }
        asm volatile("s_waitcnt lgkmcnt(0)" ::: "memory");
    }
}
__device__ __forceinline__ void transpose_small(const float* W, bf16_t* WT, int gt, int NGT) {
    for (int idx = gt; idx < 2048 * 32; idx += NGT) { const int n = idx >> 5, k0 = (idx & 31) * 8; float v[8];
#pragma unroll
        for (int e = 0; e < 8; ++e) v[e] = (k0 + e < 96) ? W[(size_t)(k0 + e) * 2048 + n] : 0.f;
        u32x4 o; o.x = cvt_pk_bf16(v[0], v[1]); o.y = cvt_pk_bf16(v[2], v[3]); o.z = cvt_pk_bf16(v[4], v[5]); o.w = cvt_pk_bf16(v[6], v[7]);
        *(u32x4*)(WT + (size_t)n * 256 + k0) = o; }
}
__device__ __forceinline__ void rope_cs(int pos, int i, float& c, float& s) {
    const float fi = (float)i, ph = fi * 0.415241003036499f, pe = __builtin_fmaf(fi, 0.415241003036499f, -ph) + fi * 8.82442119376492e-09f;
    const float inv0 = __builtin_amdgcn_exp2f(-ph), inv = inv0 - inv0 * 0.69314718f * pe;
    const float fp = (float)pos, p = fp * inv, pe2 = __builtin_fmaf(fp, inv, -p);
    const float kq = __builtin_rintf(p * 0.636619772f); const int q = (int)kq;
    float r = __builtin_fmaf(-kq, 1.5707963705062866f, p); r = __builtin_fmaf(-kq, -4.371138828673793e-08f, r); r += pe2;
    const float r2 = r * r;
    float sp = 2.7557319e-06f; sp = sp * r2 - 1.9841270e-04f; sp = sp * r2 + 8.3333333e-03f; sp = sp * r2 - 1.6666667e-01f;
    const float sn = r + r * r2 * sp;
    float cp = -2.7557319e-07f; cp = cp * r2 + 2.4801587e-05f; cp = cp * r2 - 1.3888889e-03f; cp = cp * r2 + 4.1666667e-02f; cp = cp * r2 - 0.5f;
    const float cs = 1.0f + r2 * cp;
    const int qq = q & 3;
    c = (qq == 0) ? cs : (qq == 1) ? -sn : (qq == 2) ? -cs : sn;
    s = (qq == 0) ? sn : (qq == 1) ? cs : (qq == 2) ? -sn : -cs;
}
__device__ __forceinline__ float wave_sum2(float v) { v = sum16(v); v += __shfl_xor(v, 16); v += __shfl_xor(v, 32); return v; }
__device__ __forceinline__ void ln_rows4(const float* y0, const float* g, const float* b, float* h0, bf16_t* hb0, float* st0, bool final, int lane) {
    const f32x4* yr = (const f32x4*)y0 + lane; f32x4 v[4][8]; float s[4], q[4], mu[4], rs[4];
#pragma unroll
    for (int i = 0; i < 4; ++i)
#pragma unroll
        for (int j = 0; j < 8; ++j) v[i][j] = yr[512 * i + 64 * j];
#pragma unroll
    for (int i = 0; i < 4; ++i) { s[i] = 0.f;
#pragma unroll
        for (int j = 0; j < 8; ++j) s[i] += (v[i][j][0] + v[i][j][1]) + (v[i][j][2] + v[i][j][3]); }
#pragma unroll
    for (int i = 0; i < 4; ++i) mu[i] = wave_sum2(s[i]) * (1.f / 2048.f);
#pragma unroll
    for (int i = 0; i < 4; ++i) { q[i] = 0.f;
#pragma unroll
        for (int j = 0; j < 8; ++j) { v[i][j] = v[i][j] - mu[i]; q[i] += (v[i][j][0] * v[i][j][0] + v[i][j][1] * v[i][j][1]) + (v[i][j][2] * v[i][j][2] + v[i][j][3] * v[i][j][3]); } }
#pragma unroll
    for (int i = 0; i < 4; ++i) rs[i] = 1.0f / sqrtf(wave_sum2(q[i]) * (1.f / 2048.f) + 1e-5f);
    if (!final && lane == 0) { *(f32x4*)st0 = (f32x4){mu[0], rs[0], mu[1], rs[1]}; *(f32x4*)(st0 + 4) = (f32x4){mu[2], rs[2], mu[3], rs[3]}; }
#pragma unroll
    for (int j = 0; j < 8; ++j) { const f32x4 gg = ((const f32x4*)g)[lane + 64 * j], bb = ((const f32x4*)b)[lane + 64 * j];
#pragma unroll
        for (int i = 0; i < 4; ++i) { const f32x4 o = v[i][j] * rs[i] * gg + bb;
            if (final) ((f32x4*)h0)[512 * i + lane + 64 * j] = o;
            else { u32x2 w; w.x = cvt_pk_bf16(o[0], o[1]); w.y = cvt_pk_bf16(o[2], o[3]); ((u32x2*)hb0)[512 * i + lane + 64 * j] = w; } } }
}

__device__ __forceinline__ void ln_mix_rows4(const float* y0, int row0, const float* g, const float* b, const float* mix, bf16_t* X6, float* st0, int lane) {
    asm volatile("" : "+v"(lane));
    const f32x4* yr = (const f32x4*)y0 + lane;
    const bool has_prev = (row0 & 8191) != 0; float mp = 0.f, rp = 0.f;
    if (has_prev) { float s = 0.f, q = 0.f; f32x4 t[8];
#pragma unroll
        for (int j = 0; j < 8; ++j) { t[j] = yr[64 * j - 512]; s += (t[j][0] + t[j][1]) + (t[j][2] + t[j][3]); }
        mp = wave_sum2(s) * (1.f / 2048.f);
#pragma unroll
        for (int j = 0; j < 8; ++j) { t[j] = t[j] - mp; q += (t[j][0] * t[j][0] + t[j][1] * t[j][1]) + (t[j][2] * t[j][2] + t[j][3] * t[j][3]); }
        rp = 1.0f / sqrtf(wave_sum2(q) * (1.f / 2048.f) + 1e-5f); }
    asm volatile("" ::: "memory");
    f32x4 v[4][8]; float s[4], q[4], mu[4], rs[4];
#pragma unroll
    for (int i = 0; i < 4; ++i)
#pragma unroll
        for (int j = 0; j < 8; ++j) v[i][j] = yr[512 * i + 64 * j];
#pragma unroll
    for (int i = 0; i < 4; ++i) { s[i] = 0.f;
#pragma unroll
        for (int j = 0; j < 8; ++j) s[i] += (v[i][j][0] + v[i][j][1]) + (v[i][j][2] + v[i][j][3]); }
#pragma unroll
    for (int i = 0; i < 4; ++i) mu[i] = wave_sum2(s[i]) * (1.f / 2048.f);
#pragma unroll
    for (int i = 0; i < 4; ++i) { q[i] = 0.f;
#pragma unroll
        for (int j = 0; j < 8; ++j) { v[i][j] = v[i][j] - mu[i]; q[i] += (v[i][j][0] * v[i][j][0] + v[i][j][1] * v[i][j][1]) + (v[i][j][2] * v[i][j][2] + v[i][j][3] * v[i][j][3]); } }
#pragma unroll
    for (int i = 0; i < 4; ++i) rs[i] = 1.0f / sqrtf(wave_sum2(q[i]) * (1.f / 2048.f) + 1e-5f);
    if (lane == 0) { *(f32x4*)st0 = (f32x4){mu[0], rs[0], mu[1], rs[1]}; *(f32x4*)(st0 + 4) = (f32x4){mu[2], rs[2], mu[3], rs[3]}; }
#pragma unroll
    for (int j = 0; j < 8; ++j) { int pc = lane + 64 * j; asm volatile("" : "+v"(pc)); const f32x4 gg = ((const f32x4*)g)[pc], bb = ((const f32x4*)b)[pc];
        f32x4 hp = {0.f, 0.f, 0.f, 0.f}; if (has_prev) hp = (yr[64 * j - 512] - mp) * rp * gg + bb;
        f32x4 h[4];
#pragma unroll
        for (int i = 0; i < 4; ++i) h[i] = v[i][j] * rs[i] * gg + bb;
#pragma unroll
        for (int sl = 0; sl < 6; ++sl) { const int mr = (sl == 0) ? 0 : (sl == 1) ? 2 : (sl == 2) ? 3 : (sl == 3) ? 1 : sl; const f32x4 m4 = ((const f32x4*)(mix + mr * 2048))[pc];
#pragma unroll
            for (int i = 0; i < 4; ++i) { const f32x4 pv = (i == 0) ? hp : h[i - 1]; const f32x4 o = h[i] + (pv - h[i]) * m4;
                u32x2 w; w.x = cvt_pk_bf16(o[0], o[1]); w.y = cvt_pk_bf16(o[2], o[3]);
                ((u32x2*)(X6 + (size_t)sl * (SLOT / 2) + (size_t)(row0 + i) * 2048))[pc] = w; } }
        asm volatile("" ::: "memory"); }
}

constexpr int MK_STRIDE = 400, MV_STRIDE = 144, MK_BYTES = 64 * MK_STRIDE, MV_BYTES = 128 * MV_STRIDE, MBUF = MK_BYTES + MV_BYTES;
__device__ __forceinline__ void mla_attn_phase(LAS unsigned char* lds, const bf16_t* Q, const bf16_t* KN, const bf16_t* KR, const bf16_t* VT, bf16_t* O, int G, int bx, const int tid) {
    const int lane = tid & 63, wid = __builtin_amdgcn_readfirstlane(tid >> 6), r32 = lane & 31, hi = lane >> 5;
    const int vcu = (G % 8 == 0) ? (bx % 8) * (G / 8) + bx / 8 : bx;
    for (int ui = 0;; ++ui) {
        int bh, qb;
        if (G == 256) { if (ui >= 4) break; const int s = vcu & 7; bh = vcu >> 3; qb = (ui == 0) ? s : (ui == 1) ? 15 - s : (ui == 2) ? 16 + s : 31 - s; }
        else { const int L = ui * G + bx; if (L >= 1024) break; bh = L & 31; qb = 31 - (L >> 5); }
        const int b = bh >> 4, h = bh & 15; const size_t rowbase = (size_t)b * SEQ; const int q0 = qb * 256 + wid * 32;
        bf16x8 qf[12];
        { const bf16_t* qp = Q + (rowbase + q0 + r32) * 3072 + h * 192 + hi * 8;
#pragma unroll
            for (int d0 = 0; d0 < 12; ++d0) qf[d0] = *(const bf16x8*)(qp + d0 * 16); }
        const int NT = 4 * (qb + 1);
        f32x16 o[4];
#pragma unroll
        for (int i = 0; i < 4; ++i)
#pragma unroll
            for (int r = 0; r < 16; ++r) o[i][r] = 0.f;
        float mrun = -1e30f, lrun = 0.f;
        u32x4 kreg[3], vreg[2];
        const int kkey = tid >> 4, kpc = tid & 15, rkey = tid >> 3, rpc = tid & 7;
        const bf16_t* kn0 = KN + (rowbase + kkey) * 2048 + h * 128 + kpc * 8;
        const bf16_t* kr0 = KR + (rowbase + rkey) * 64 + rpc * 8;
        const bf16_t* vt0 = VT + ((size_t)(bh * 128 + (tid >> 3))) * 8192 + (tid & 7) * 8;
#define MLA_LOAD(j) do { kreg[0] = *(const u32x4*)(kn0 + (size_t)(64 * (j)) * 2048); kreg[1] = *(const u32x4*)(kn0 + (size_t)(64 * (j) + 32) * 2048); kreg[2] = *(const u32x4*)(kr0 + (size_t)(64 * (j)) * 64); \
        vreg[0] = *(const u32x4*)(vt0 + 64 * (j)); vreg[1] = *(const u32x4*)(vt0 + (size_t)64 * 8192 + 64 * (j)); } while (0)
#define MLA_STORE(buf) do { LAS unsigned char* kb_ = lds + (buf) * MBUF; LAS unsigned char* vb_ = kb_ + MK_BYTES; \
        *(LAS u32x4*)(kb_ + kkey * MK_STRIDE + kpc * 16) = kreg[0]; *(LAS u32x4*)(kb_ + (kkey + 32) * MK_STRIDE + kpc * 16) = kreg[1]; *(LAS u32x4*)(kb_ + rkey * MK_STRIDE + 256 + rpc * 16) = kreg[2]; \
        { LAS unsigned char* p_ = vb_ + (tid >> 3) * MV_STRIDE + ((tid & 7) >> 1) * 32 + (tid & 1) * 8; *(LAS u32x2*)p_ = (u32x2){vreg[0].x, vreg[0].y}; *(LAS u32x2*)(p_ + 16) = (u32x2){vreg[0].z, vreg[0].w}; \
          p_ += 64 * MV_STRIDE; *(LAS u32x2*)p_ = (u32x2){vreg[1].x, vreg[1].y}; *(LAS u32x2*)(p_ + 16) = (u32x2){vreg[1].z, vreg[1].w}; } } while (0)
        MLA_LOAD(0); MLA_STORE(0);
        __syncthreads();
        for (int j = 0; j < NT; ++j) {
            const int buf = j & 1;
            if (j + 1 < NT) MLA_LOAD(j + 1);
            if (64 * j <= q0 + 31) {
                const LAS unsigned char* kb = lds + buf * MBUF; const LAS unsigned char* vb = kb + MK_BYTES;
                f32x16 st[2];
#pragma unroll
                for (int kvh = 0; kvh < 2; ++kvh)
#pragma unroll
                    for (int r = 0; r < 16; ++r) st[kvh][r] = 0.f;
                { const LAS unsigned char* kp0 = kb + r32 * MK_STRIDE + hi * 16; const LAS unsigned char* kp1 = kp0 + 32 * MK_STRIDE;
#define MLA_KF(i) (*(const LAS bf16x8*)((((i) & 1) ? kp1 : kp0) + ((i) >> 1) * 32))
                    bf16x8 kq[6];
#pragma unroll
                    for (int i = 0; i < 6; ++i) kq[i] = MLA_KF(i);
                    __builtin_amdgcn_sched_barrier(0);
#pragma unroll
                    for (int i = 0; i < 24; ++i) { st[i & 1] = __builtin_amdgcn_mfma_f32_32x32x16_bf16(kq[i % 6], qf[i >> 1], st[i & 1], 0, 0, 0);
                        if (i + 6 < 24) kq[i % 6] = MLA_KF(i + 6);
                        __builtin_amdgcn_sched_barrier(0); }
#undef MLA_KF
                }
                if (64 * j + 63 > q0) {
                    const int qg = q0 + r32;
#pragma unroll
                    for (int kvh = 0; kvh < 2; ++kvh)
#pragma unroll
                        for (int r = 0; r < 16; ++r) { const int kg = 64 * j + 32 * kvh + crow(r, hi); if (kg > qg) st[kvh][r] = -1e30f; }
                }
                const LAS unsigned char* vp0 = vb + r32 * MV_STRIDE + hi * 16;
#define MLA_VF(i) (*(const LAS bf16x8*)(vp0 + ((i) & 3) * (32 * MV_STRIDE) + ((i) >> 2) * 32))
                bf16x8 vq[4];
#pragma unroll
                for (int i = 0; i < 4; ++i) vq[i] = MLA_VF(i);
                float mx = st[0][0];
#pragma unroll
                for (int r = 1; r < 16; ++r) mx = fmaxf(mx, st[0][r]);
#pragma unroll
                for (int r = 0; r < 16; ++r) mx = fmaxf(mx, st[1][r]);
                mx = fmaxf(mx, __shfl_xor(mx, 32));
                const float mnew = (mx > mrun + 8.0f) ? mx : mrun;
                if (__any(mnew != mrun)) { const float alpha = __builtin_amdgcn_exp2f(mrun - mnew); lrun *= alpha;
#pragma unroll
                    for (int i = 0; i < 4; ++i)
#pragma unroll
                        for (int r = 0; r < 16; ++r) o[i][r] *= alpha;
                    mrun = mnew; }
                float ps = 0.f;
#pragma unroll
                for (int kvh = 0; kvh < 2; ++kvh)
#pragma unroll
                    for (int r = 0; r < 16; ++r) { const float p = __builtin_amdgcn_exp2f(st[kvh][r] - mrun); st[kvh][r] = p; ps += p; }
                lrun += ps;
                bf16x8 pf[4];
#pragma unroll
                for (int ks = 0; ks < 4; ++ks) { const int kvh = ks >> 1, rb = 8 * (ks & 1); u32x4 w;
                    w.x = cvt_pk_bf16(st[kvh][rb + 0], st[kvh][rb + 1]); w.y = cvt_pk_bf16(st[kvh][rb + 2], st[kvh][rb + 3]); w.z = cvt_pk_bf16(st[kvh][rb + 4], st[kvh][rb + 5]); w.w = cvt_pk_bf16(st[kvh][rb + 6], st[kvh][rb + 7]);
                    pf[ks] = __builtin_bit_cast(bf16x8, w); }
                __builtin_amdgcn_sched_barrier(0);
#pragma unroll
                for (int i = 0; i < 16; ++i) { o[i & 3] = __builtin_amdgcn_mfma_f32_32x32x16_bf16(vq[i % 4], pf[i >> 2], o[i & 3], 0, 0, 0);
                    if (i + 4 < 16) vq[i % 4] = MLA_VF(i + 4);
                    __builtin_amdgcn_sched_barrier(0); }
#undef MLA_VF
            }
            if (j + 1 < NT) MLA_STORE(buf ^ 1);
            __syncthreads();
        }
        lrun += __shfl_xor(lrun, 32);
        const float inv = 1.0f / lrun;
        bf16_t* op = O + (rowbase + q0 + r32) * 2048 + h * 128 + 4 * hi;
#pragma unroll
        for (int dvb = 0; dvb < 4; ++dvb)
#pragma unroll
            for (int g4 = 0; g4 < 4; ++g4) { u32x2 w; w.x = cvt_pk_bf16(o[dvb][4 * g4] * inv, o[dvb][4 * g4 + 1] * inv); w.y = cvt_pk_bf16(o[dvb][4 * g4 + 2] * inv, o[dvb][4 * g4 + 3] * inv);
                *(u32x2*)(op + 32 * dvb + 8 * g4) = w; }
#undef MLA_LOAD
#undef MLA_STORE
    }
}

constexpr int SK_STRIDE = 144, SV_STRIDE = 520, SK_BYTES = 256 * SK_STRIDE, SV_BYTES = 64 * SV_STRIDE, SB_OFF = SK_BYTES + SV_BYTES;
__device__ __forceinline__ void swa_attn_phase(LAS unsigned char* lds, const bf16_t* Q, const bf16_t* Kg, const bf16_t* VT, bf16_t* O, const float* bt2, const float* sinks, int G, int bx, const int tid) {
    const int lane = tid & 63, wid = __builtin_amdgcn_readfirstlane(tid >> 6), r32 = lane & 31, hi = lane >> 5;
    LAS unsigned char* ks_ = lds; LAS unsigned char* vs_ = lds + SK_BYTES; LAS float* bs_ = (LAS float*)(lds + SB_OFF);
    for (int L = bx; L < 512; L += G) {
        const int hk = L & 3, blk = (L >> 2) & 63, b = L >> 8;
        const size_t rowbase = (size_t)b * SEQ; const int t0 = blk * 128 - 128;
#pragma unroll
        for (int i = 0; i < 4; ++i) { const int p = tid + 512 * i, key = p >> 3, pc = p & 7; u32x4 v = {0u, 0u, 0u, 0u};
            if (t0 + key >= 0) v = *(const u32x4*)(Kg + (rowbase + t0 + key) * 256 + hk * 64 + pc * 8);
            *(LAS u32x4*)(ks_ + key * SK_STRIDE + pc * 16) = v; }
#pragma unroll
        for (int i = 0; i < 4; ++i) { const int p = tid + 512 * i, dv = p >> 5, pc = p & 31; u32x4 v = {0u, 0u, 0u, 0u};
            if (t0 + pc * 8 >= 0) v = *(const u32x4*)(VT + ((size_t)((b * 4 + hk) * 64 + dv)) * 8192 + t0 + pc * 8);
            LAS unsigned char* p_ = vs_ + dv * SV_STRIDE + pc * 16; *(LAS u32x2*)p_ = (u32x2){v.x, v.y}; *(LAS u32x2*)(p_ + 8) = (u32x2){v.z, v.w}; }
        for (int i = tid; i < 1024; i += 512) bs_[i] = bt2[(hk * 8) * 128 + i];
        __syncthreads();
        for (int ci = 0; ci < 4; ++ci) {
            const int c = wid + 8 * ci, g = c >> 2, qs = c & 3, head = hk * 8 + g;
            const size_t qrow = rowbase + blk * 128 + 32 * qs + r32;
            bf16x8 qf[4];
#pragma unroll
            for (int d0 = 0; d0 < 4; ++d0) qf[d0] = *(const bf16x8*)(Q + qrow * 2048 + head * 64 + d0 * 16 + hi * 8);
            const float sink2 = sinks[head] * LOG2E;
            float mrun = sink2, lrun = (hi == 0) ? 1.0f : 0.0f;
            f32x16 o[2];
#pragma unroll
            for (int i = 0; i < 2; ++i)
#pragma unroll
                for (int r = 0; r < 16; ++r) o[i][r] = 0.f;
#pragma unroll 1
            for (int kb = 0; kb < 5; ++kb) {
                f32x16 st;
#pragma unroll
                for (int r = 0; r < 16; ++r) st[r] = 0.f;
                const LAS unsigned char* kp_ = ks_ + (32 * (qs + kb) + r32) * SK_STRIDE + hi * 16;
#pragma unroll
                for (int d0 = 0; d0 < 4; ++d0) { const bf16x8 kf = *(const LAS bf16x8*)(kp_ + d0 * 32); st = __builtin_amdgcn_mfma_f32_32x32x16_bf16(kf, qf[d0], st, 0, 0, 0); }
                float mx = -1e30f;
#pragma unroll
                for (int r = 0; r < 16; ++r) { const int kl = 32 * kb + crow(r, hi);
                    const int dist = r32 + 128 - kl; const bool ok = (dist >= 0) && (dist < 128) && (t0 + 32 * qs + kl >= 0);
                    const float bv = bs_[g * 128 + (dist & 127)];
                    const float sv = ok ? st[r] + bv : -1e30f; st[r] = sv; mx = fmaxf(mx, sv); }
                mx = fmaxf(mx, __shfl_xor(mx, 32));
                const float mnew = fmaxf(mrun, mx), alpha = __builtin_amdgcn_exp2f(mrun - mnew); mrun = mnew;
                float ps = 0.f;
#pragma unroll
                for (int r = 0; r < 16; ++r) { const float p = __builtin_amdgcn_exp2f(st[r] - mnew); st[r] = p; ps += p; }
                lrun = lrun * alpha + ps;
#pragma unroll
                for (int i = 0; i < 2; ++i)
#pragma unroll
                    for (int r = 0; r < 16; ++r) o[i][r] *= alpha;
#pragma unroll
                for (int k2 = 0; k2 < 2; ++k2) { const int rb = 8 * k2; u32x4 w;
                    w.x = cvt_pk_bf16(st[rb + 0], st[rb + 1]); w.y = cvt_pk_bf16(st[rb + 2], st[rb + 3]); w.z = cvt_pk_bf16(st[rb + 4], st[rb + 5]); w.w = cvt_pk_bf16(st[rb + 6], st[rb + 7]);
                    const bf16x8 pf = __builtin_bit_cast(bf16x8, w);
#pragma unroll
                    for (int dvb = 0; dvb < 2; ++dvb) { const LAS unsigned char* vp = vs_ + (32 * dvb + r32) * SV_STRIDE + (32 * (qs + kb) + 16 * k2 + 4 * hi) * 2;
                        const u32x2 lo = *(const LAS u32x2*)vp, hi2 = *(const LAS u32x2*)(vp + 16); const u32x4 vw = {lo.x, lo.y, hi2.x, hi2.y};
                        o[dvb] = __builtin_amdgcn_mfma_f32_32x32x16_bf16(__builtin_bit_cast(bf16x8, vw), pf, o[dvb], 0, 0, 0); } }
            }
            lrun += __shfl_xor(lrun, 32);
            const float inv = 1.0f / lrun;
            bf16_t* op = O + qrow * 2048 + head * 64 + 4 * hi;
#pragma unroll
            for (int dvb = 0; dvb < 2; ++dvb)
#pragma unroll
                for (int g4 = 0; g4 < 4; ++g4) { u32x2 w; w.x = cvt_pk_bf16(o[dvb][4 * g4] * inv, o[dvb][4 * g4 + 1] * inv); w.y = cvt_pk_bf16(o[dvb][4 * g4 + 2] * inv, o[dvb][4 * g4 + 3] * inv);
                    *(u32x2*)(op + 32 * dvb + 8 * g4) = w; }
        }
        __syncthreads();
    }
}

__device__ __forceinline__ void rwkv_mix_phase(const float* y, const float* stats, const float* lg, const float* lb, const float* mix, bf16_t* X6, int gt, int NGT) {
    for (int idx = gt; idx < M * 256; idx += NGT) { const int row = idx >> 8, c = (idx & 255) * 8; const size_t off = (size_t)row * 2048 + c;
        const f32x4 g0 = *(const f32x4*)(lg + c), g1 = *(const f32x4*)(lg + c + 4), b0 = *(const f32x4*)(lb + c), b1 = *(const f32x4*)(lb + c + 4);
        const f32x2 ms = *(const f32x2*)(stats + 2 * (size_t)row);
        const f32x4 x0 = (*(const f32x4*)(y + off) - ms[0]) * ms[1] * g0 + b0, x1 = (*(const f32x4*)(y + off + 4) - ms[0]) * ms[1] * g1 + b1; f32x4 p0 = {0.f, 0.f, 0.f, 0.f}, p1 = p0;
        if ((row & 8191) != 0) { const f32x2 mp = *(const f32x2*)(stats + 2 * (size_t)row - 2); p0 = (*(const f32x4*)(y + off - 2048) - mp[0]) * mp[1] * g0 + b0; p1 = (*(const f32x4*)(y + off - 2044) - mp[0]) * mp[1] * g1 + b1; }
        const f32x4 d0 = p0 - x0, d1 = p1 - x1;
#pragma unroll
        for (int s = 0; s < 6; ++s) { const int mr = (s == 0) ? 0 : (s == 1) ? 2 : (s == 2) ? 3 : (s == 3) ? 1 : s;
            const f32x4 m0 = *(const f32x4*)(mix + mr * 2048 + c), m1 = *(const f32x4*)(mix + mr * 2048 + c + 4);
            *(u32x4*)(X6 + (size_t)s * (SLOT / 2) + off) = pack8(x0 + d0 * m0, x1 + d1 * m1); }
    }
}
constexpr int SC_T = 32, SC_TOK = 1536, SC_BUF = SC_T * SC_TOK;
__device__ __forceinline__ void rwkv_scan_phase(LAS unsigned char* lds, const bf16_t* RKV, const float* DEC, const float* AF, const float* k_k, const float* k_a, const float* r_k, float* BON, float* Y, int bx, const int tid) {
    const int lane = tid & 63, wid = __builtin_amdgcn_readfirstlane(tid >> 6);
    const int bh = bx >> 2, rq = bx & 3, b = bh >> 5, h = bh & 31; const size_t rowbase = (size_t)b * SEQ;
    const int ptid = tid - 256, ptok = ptid >> 4, pc4 = (ptid & 15) * 4;
    f32x4 kk4 = {0.f, 0.f, 0.f, 0.f}, ka4 = kk4, rk4 = kk4;
    if (wid >= 4) { kk4 = *(const f32x4*)(k_k + h * 64 + pc4); ka4 = *(const f32x4*)(k_a + h * 64 + pc4); rk4 = *(const f32x4*)(r_k + h * 64 + pc4); }
    u32x2 prw[2], pkw[2], pvw[2]; f32x4 pw4[2], pa4[2];
#pragma unroll
    for (int i = 0; i < 2; ++i) { prw[i] = (u32x2){0u, 0u}; pkw[i] = prw[i]; pvw[i] = prw[i]; pw4[i] = (f32x4){0.f, 0.f, 0.f, 0.f}; pa4[i] = pw4[i]; }
#define SCAN_LOAD(c) do { _Pragma("unroll") for (int ps_ = 0; ps_ < 2; ++ps_) { const int tl = ptok + 16 * ps_; const size_t off = (rowbase + (size_t)(c) * SC_T + tl) * 2048 + h * 64 + pc4; \
        prw[ps_] = *(const u32x2*)(RKV + off); pkw[ps_] = *(const u32x2*)(RKV + (SLOT / 2) + off); pvw[ps_] = *(const u32x2*)(RKV + 2 * (SLOT / 2) + off); \
        pw4[ps_] = *(const f32x4*)(DEC + off); pa4[ps_] = *(const f32x4*)(AF + off); } } while (0)
#define SCAN_STORE(buf, c) do { _Pragma("unroll") for (int ps_ = 0; ps_ < 2; ++ps_) { const int tl = ptok + 16 * ps_; const u32x2 rw = prw[ps_], kw = pkw[ps_], vw = pvw[ps_]; const f32x4 w4 = pw4[ps_], a4 = pa4[ps_]; \
        const f32x4 r4 = {bflo(rw.x), bfhi(rw.x), bflo(rw.y), bfhi(rw.y)}, k4 = {bflo(kw.x), bfhi(kw.x), bflo(kw.y), bfhi(kw.y)}, v4 = {bflo(vw.x), bfhi(vw.x), bflo(vw.y), bfhi(vw.y)}; \
        const f32x4 kr = k4 * kk4; float ss = (kr[0] * kr[0] + kr[1] * kr[1]) + (kr[2] * kr[2] + kr[3] * kr[3]); ss = sum16(ss); \
        const float rn = 1.0f / fmaxf(sqrtf(ss), 1e-12f); const f32x4 kn = kr * rn; const f32x4 kp = k4 * (1.0f + (a4 - 1.0f) * ka4); \
        { const f32x4 tb = r4 * kp * rk4; const float bon = sum16((tb[0] + tb[1]) + (tb[2] + tb[3])); if (rq == 0 && pc4 == 0) BON[(rowbase + (size_t)(c) * SC_T + tl) * 32 + h] = bon; } \
        LAS unsigned char* d_ = lds + (buf) * SC_BUF + tl * SC_TOK + pc4 * 4; \
        *(LAS f32x4*)(d_) = r4; *(LAS f32x4*)(d_ + 256) = w4; *(LAS f32x4*)(d_ + 512) = kp; *(LAS f32x4*)(d_ + 768) = v4; *(LAS f32x4*)(d_ + 1024) = -kn; *(LAS f32x4*)(d_ + 1280) = kn * a4; } } while (0)
    const int ks4 = (lane & 15) * 16, rowi = 16 * rq + 4 * wid + (lane >> 4);
    f32x2 S01 = {0.f, 0.f}, S23 = {0.f, 0.f};
    float* yp = Y + rowbase * 2048 + h * 64 + rowi;
    if (wid >= 4) { SCAN_LOAD(0); SCAN_STORE(0, 0); SCAN_LOAD(1); }
    __syncthreads();
    for (int c = 0; c < SEQ / SC_T; ++c) {
        if (wid >= 4) { if (c + 1 < SEQ / SC_T) { SCAN_STORE((c + 1) & 1, c + 1); if (c + 2 < SEQ / SC_T) SCAN_LOAD(c + 2); } }
        else {
            const LAS unsigned char* base = lds + (c & 1) * SC_BUF + ks4; const LAS unsigned char* vbase = lds + (c & 1) * SC_BUF + 768 + rowi * 4;
            f32x4 r4 = *(const LAS f32x4*)(base), w4 = *(const LAS f32x4*)(base + 256), k4 = *(const LAS f32x4*)(base + 512), a4 = *(const LAS f32x4*)(base + 1024), b4 = *(const LAS f32x4*)(base + 1280);
            float vv = *(const LAS float*)(vbase); float ykeep = 0.f;
#pragma unroll
            for (int t = 0; t < SC_T; ++t) {
                f32x4 r4n = r4, w4n = w4, k4n = k4, a4n = a4, b4n = b4; float vvn = vv;
                if (t + 1 < SC_T) { const LAS unsigned char* p = base + (t + 1) * SC_TOK;
                    r4n = *(const LAS f32x4*)(p); w4n = *(const LAS f32x4*)(p + 256); k4n = *(const LAS f32x4*)(p + 512); a4n = *(const LAS f32x4*)(p + 1024); b4n = *(const LAS f32x4*)(p + 1280);
                    vvn = *(const LAS float*)(vbase + (t + 1) * SC_TOK); }
                const f32x2 a01 = {a4[0], a4[1]}, a23 = {a4[2], a4[3]}, w01 = {w4[0], w4[1]}, w23 = {w4[2], w4[3]}, b01 = {b4[0], b4[1]}, b23 = {b4[2], b4[3]}, k01 = {k4[0], k4[1]}, k23 = {k4[2], k4[3]}, r01 = {r4[0], r4[1]}, r23 = {r4[2], r4[3]};
                const f32x2 tsa = S01 * a01 + S23 * a23; const float sa = sum16(tsa[0] + tsa[1]);
                S01 = S01 * w01 + (b01 * sa + k01 * vv); S23 = S23 * w23 + (b23 * sa + k23 * vv);
                const f32x2 ty = S01 * r01 + S23 * r23; const float y = sum16(ty[0] + ty[1]);
                ykeep = ((lane & 15) == (t & 15)) ? y : ykeep;
                if ((t & 15) == 15) yp[(size_t)(c * SC_T + (t - 15) + (lane & 15)) * 2048] = ykeep;
                r4 = r4n; w4 = w4n; k4 = k4n; a4 = a4n; b4 = b4n; vv = vvn;
            }
        }
        __syncthreads();
    }
#undef SCAN_LOAD
#undef SCAN_STORE
}
__device__ __forceinline__ void rwkv_gn_phase(const float* Y, const bf16_t* Vb, const float* BON, const bf16_t* GB, const float* ln_g, const float* ln_b, bf16_t* YG, int gw, int NGW, int lane) {
    const int c4 = (lane & 15) * 4, sub = lane >> 4;
    for (int it = gw * 4 + sub; it < M * 32; it += NGW * 4) { const int row = it >> 5, h = it & 31; const int ch = h * 64 + c4; const size_t off = (size_t)row * 2048 + ch;
        const f32x4 y4 = *(const f32x4*)(Y + off);
        const u32x2 vw = *(const u32x2*)(Vb + off), gw2 = *(const u32x2*)(GB + off); const float bonus = BON[it];
        const f32x4 lg = *(const f32x4*)(ln_g + ch), lb = *(const f32x4*)(ln_b + ch);
        const float mean = sum16((y4[0] + y4[1]) + (y4[2] + y4[3])) * (1.f / 64.f); const f32x4 d = y4 - mean;
        const float var = sum16((d[0] * d[0] + d[1] * d[1]) + (d[2] * d[2] + d[3] * d[3])) * (1.f / 64.f); const float rstd = 1.0f / sqrtf(var + 64e-5f);
        const f32x4 v4 = {bflo(vw.x), bfhi(vw.x), bflo(vw.y), bfhi(vw.y)}, g4 = {bflo(gw2.x), bfhi(gw2.x), bflo(gw2.y), bfhi(gw2.y)};
        const f32x4 outv = (d * rstd * lg + lb + v4 * bonus) * g4;
        u32x2 w; w.x = cvt_pk_bf16(outv[0], outv[1]); w.y = cvt_pk_bf16(outv[2], outv[3]); *(u32x2*)(YG + off) = w; }
}

#define XB_TMO      128
#define XB_XCNT(j)  (256  + 64 * (j))
#define XB_XSUB(j)  (1280 + 64 * (j))
#define XB_XGEN(j)  (2304 + 64 * (j))
#define XB_TOP      3328
#define XB_TOPGEN   3392
#define XCD_BAR_WORDS 3456
#define XB_SPIN_CAP (1u << 18)
__device__ __forceinline__ unsigned xb_ld(unsigned* p)              { return __hip_atomic_load(p, __ATOMIC_RELAXED, __HIP_MEMORY_SCOPE_AGENT); }
__device__ __forceinline__ unsigned xb_add(unsigned* p, unsigned v) { return __hip_atomic_fetch_add(p, v, __ATOMIC_RELAXED, __HIP_MEMORY_SCOPE_AGENT); }
__device__ __forceinline__ unsigned xb_xcc_id() { return (unsigned)__builtin_amdgcn_s_getreg((3 << 11) | 20) & 0xFu; }
#define XB_SPIN(cond, bar) do { unsigned _sp = 0; while (cond) { __builtin_amdgcn_s_sleep(1); \
    if ((++_sp & 255u) == 0u) { if (xb_ld(&(bar)[XB_TMO])) break; if (_sp > XB_SPIN_CAP) { atomicAdd(&(bar)[XB_TMO], 1u); break; } } } } while (0)
struct XcdBarrier { unsigned* bar; unsigned x; volatile LAS unsigned* st; };
__device__ __forceinline__ XcdBarrier xcd_barrier_post(unsigned* bar, volatile LAS unsigned* st) {
    XcdBarrier b; b.bar = bar; b.x = xb_xcc_id(); b.st = st;
    if (threadIdx.x == 0) (void)xb_add(&bar[XB_XCNT(b.x)], 1u);
    return b;
}
__device__ __forceinline__ void xcd_barrier_complete(unsigned* bar, unsigned x, unsigned& nloc, unsigned& nx) {
    const unsigned G = gridDim.x * gridDim.y * gridDim.z;
    unsigned sum, cnt, mine, sp = 0u;
    for (;;) {
        sum = 0u; cnt = 0u; mine = 0u;
#pragma unroll
        for (unsigned j = 0; j < 16; ++j) { const unsigned c = xb_ld(&bar[XB_XCNT(j)]); sum += c; cnt += (c > 0u) ? 1u : 0u; mine = (j == x) ? c : mine; }
        if (sum == G) break;
        __builtin_amdgcn_s_sleep(1);
        if ((++sp & 255u) == 0u) { if (xb_ld(&bar[XB_TMO])) break; if (sp > XB_SPIN_CAP) { atomicAdd(&bar[XB_TMO], 1u); break; } }
    }
    nloc = mine > 0u ? mine : 1u; nx = cnt > 0u ? cnt : 1u;
}
__device__ __forceinline__ void xcd_barrier(const XcdBarrier& b) {
    asm volatile("s_waitcnt vmcnt(0)" ::: "memory");
    __syncthreads();
    if (threadIdx.x == 0) {
        unsigned* bar = b.bar;
        __builtin_amdgcn_s_waitcnt(0);
        unsigned nloc = b.st[0], nx = b.st[1];
        if (nloc == 0u) { xcd_barrier_complete(bar, b.x, nloc, nx); b.st[0] = nloc; b.st[1] = nx; }
        const unsigned old = xb_add(&bar[XB_XSUB(b.x)], 1u);
        const unsigned gen = old / nloc;
        if (old + 1u == (gen + 1u) * nloc) {
            __builtin_amdgcn_fence(__ATOMIC_RELEASE, "agent");
            asm volatile("s_waitcnt vmcnt(0)" ::: "memory");
            const unsigned og = xb_add(&bar[XB_TOP], 1u);
            const unsigned tg = og / nx;
            if (og + 1u == (tg + 1u) * nx) xb_add(&bar[XB_TOPGEN], 1u);
            else XB_SPIN(xb_ld(&bar[XB_TOPGEN]) == tg, bar);
            __builtin_amdgcn_fence(__ATOMIC_ACQUIRE, "agent");
            xb_add(&bar[XB_XGEN(b.x)], 1u);
            asm volatile("s_waitcnt vmcnt(0)" ::: "memory");
        } else {
            XB_SPIN(xb_ld(&bar[XB_XGEN(b.x)]) == gen, bar);
            __builtin_amdgcn_fence(__ATOMIC_ACQUIRE, "agent");
            asm volatile("s_waitcnt vmcnt(0)" ::: "memory");
        }
    }
    __syncthreads();
}

struct Args { const float* in[33]; float* out; unsigned char* ws; int ph_lo, ph_hi; };
#ifndef PROBE_N
#define PROBE_N 0
#define PROBE_MAP(i) 0
#endif
constexpr int N_PHASES = 36 + PROBE_N;
typedef const __attribute__((address_space(4))) unsigned char* kargp_t;
#define IN(i) (*(const float* const __attribute__((address_space(4)))*)(kp + 8 * (i)))
__global__ void __launch_bounds__(512, 2) hybrid_fwd(Args args) {
    extern __shared__ __attribute__((aligned(16))) unsigned char lds_raw[];
    LAS unsigned char* lds = (LAS unsigned char*)lds_raw;
    cg::grid_group grid = cg::this_grid();
    const kargp_t karg = (kargp_t)__builtin_amdgcn_kernarg_segment_ptr();
    const int ph_lo = args.ph_lo, ph_hi = args.ph_hi;
    volatile LAS unsigned* MISC = (volatile LAS unsigned*)(lds + LDS_BYTES - 256);
    if (threadIdx.x < 64) MISC[threadIdx.x] = 0u;
    __syncthreads();
    const XcdBarrier xb = xcd_barrier_post((unsigned*)(args.ws + WS_BAR), MISC + 8);

    for (int phx = ph_lo; phx < ph_hi; ++phx) {
        const int ph = (phx < 36) ? phx : (PROBE_MAP(phx - 36));
        int tid = threadIdx.x; asm volatile("" : "+v"(tid));
        const int lane = tid & 63, wave = __builtin_amdgcn_readfirstlane(tid >> 6);
        int G = gridDim.x, bx = blockIdx.x; asm volatile("" : "+s"(G), "+s"(bx));
        const int gw = bx * 8 + wave, NGW = G * 8, gt = bx * 512 + tid, NGT = G * 512;
        LAS float* scr = (LAS float*)(lds + wave * 16640);
        kargp_t kp = karg; asm volatile("" : "+s"(kp));
        float* hout = *(float* const __attribute__((address_space(4)))*)(kp + 8 * 33); unsigned char* ws = *(unsigned char* const __attribute__((address_space(4)))*)(kp + 8 * 34);
        unsigned char* ar = ws + WS_AR; const float* x_in = IN(0);
        bf16_t* HB = (bf16_t*)(ws + WS_HB); float* Yb = (float*)(ws + WS_Y);
        float* tab = (float*)(ws + WS_TAB); float* bt2 = (float*)(ws + WS_BT); float* stats = (float*)(ws + WS_STATS);
        int layer, kind, sub;
        if (ph == 0 || ph >= 100) { layer = -1; kind = -1; sub = 0; }
        else if (ph < 10) { layer = 0; kind = 0; sub = ph - 1; }
        else if (ph < 20) { layer = 1; kind = 1; sub = ph - 10; }
        else if (ph < 27) { layer = 2; kind = 2; sub = ph - 20; }
        else { layer = 3; kind = 0; sub = ph - 27; }
        const int nsub = (kind == 0) ? 9 : (kind == 1) ? 10 : 7;
        const int tail = sub - (nsub - 4);
        const bool nosync = (kind == 0 && sub == 2) || (kind == 1 && sub == 1);
        if (phx > ph_lo && !nosync) { if (phx == 1) grid.sync(); else xcd_barrier(xb); }
        const float* hres = (layer <= 0) ? x_in : Yb;
        const float* rg = (layer <= 0) ? nullptr : IN(29) + (size_t)((layer - 1) * 2 + 1) * 2048; const float* rb = (layer <= 0) ? nullptr : IN(30) + (size_t)((layer - 1) * 2 + 1) * 2048;
        pg8::Gemm g0{}; EpiP e0{}; int ng = 0;

        if (ph >= 100) {
        } else if (ph == 0) {
            for (int job = 0; job < 18; ++job) {
                const float* W = nullptr; int Ks = 0, Ns = 0, ldwt = 0, Nd = 0, kd = 0; const float* rs = nullptr; bf16_t* WT = nullptr;
                if (job < 8) { const int j = job >> 2, w = job & 3; unsigned char* base = ws + WS_MLA_W + (size_t)j * 20 * MiB;
                    if (w == 0) { W = IN(1) + (size_t)j * 2048 * 1088; Ks = 2048; Ns = 1088; WT = (bf16_t*)base; ldwt = 2048; Nd = 1280; kd = 1; }
                    else if (w == 1) { W = IN(4) + (size_t)j * 512 * 3072; Ks = 512; Ns = 3072; WT = (bf16_t*)(base + 5 * MiB); ldwt = 512; Nd = 3072; kd = 2; rs = IN(2) + j * 512; }
                    else if (w == 2) { W = IN(5) + (size_t)j * 512 * 4096; Ks = 512; Ns = 4096; WT = (bf16_t*)(base + 8 * MiB); ldwt = 512; Nd = 4096; kd = 0; rs = IN(3) + j * 512; }
                    else { W = IN(6) + (size_t)j * 2048 * 2048; Ks = 2048; Ns = 2048; WT = (bf16_t*)(base + 12 * MiB); ldwt = 2048; Nd = 2048; kd = 0; } }
                else if (job < 11) { const int n = job - 8; W = IN(8) + (size_t)n * 2048 * 2048; Ks = 2048; Ns = 2048; WT = (bf16_t*)(ws + WS_RW_W) + (size_t)n * 2048 * 2048; ldwt = 2048; Nd = 2048; }
                else if (job == 11) { W = IN(10); Ks = 2048; Ns = 96; WT = (bf16_t*)(ws + WS_RW_W + 24 * MiB); ldwt = 2048; Nd = 256; }
                else if (job == 12) { W = IN(13); Ks = 2048; Ns = 96; WT = (bf16_t*)(ws + WS_RW_W + 24 * MiB) + (size_t)256 * 2048; ldwt = 2048; Nd = 256; }
                else if (job == 13) { W = IN(15); Ks = 2048; Ns = 256; WT = (bf16_t*)(ws + WS_RW_W + 24 * MiB) + (size_t)512 * 2048; ldwt = 2048; Nd = 256; }
                else if (job == 14) { W = IN(16); Ks = 256; Ns = 2048; WT = (bf16_t*)(ws + WS_RW_W + 27 * MiB) + (size_t)4096 * 256; ldwt = 256; Nd = 2048; }
                else if (job == 15) { W = IN(22); Ks = 2048; Ns = 2048; WT = (bf16_t*)(ws + WS_RW_W + 30 * MiB); ldwt = 2048; Nd = 2048; }
                else if (job == 16) { W = IN(23); Ks = 2048; Ns = 2560; WT = (bf16_t*)(ws + WS_SW_W); ldwt = 2048; Nd = 2560; }
                else { W = IN(26); Ks = 2048; Ns = 2048; WT = (bf16_t*)(ws + WS_SW_W + 10 * MiB); ldwt = 2048; Nd = 2048; }
                transpose_w(W, Ks, Ns, WT, ldwt, Nd, kd, rs, scr, gw, NGW, lane);
            }
            transpose_small(IN(11), (bf16_t*)(ws + WS_RW_W + 27 * MiB), gt, NGT);
            transpose_small(IN(14), (bf16_t*)(ws + WS_RW_W + 27 * MiB) + (size_t)2048 * 256, gt, NGT);
            for (int idx = gt; idx < 8192 * 32; idx += NGT) { const int pos = idx >> 5, i = idx & 31;
                float c, s; rope_cs(pos, i, c, s);
                tab[2 * idx] = c; tab[2 * idx + 1] = s; }
            { const float* rb = IN(28);
            for (int idx = gt; idx < 32 * 128; idx += NGT) { const int hd = idx >> 7, n = idx & 127; int bucket;
                if (n < 16) bucket = n; else { const float nf = (float)n; int lg = 16 + (int)(logf(nf / 16.0f) / 2.0794415416798357f * 16.0f); lg = lg < 31 ? lg : 31; bucket = lg; }
                bt2[idx] = rb[bucket * 32 + hd] * LOG2E; } }
            for (int idx = gt; idx < M * 256; idx += NGT) { const size_t off = (size_t)idx * 8; *(u32x4*)(HB + off) = pack8(*(const f32x4*)(x_in + off), *(const f32x4*)(x_in + off + 4)); }
        } else if (tail == 0 || tail == 3) {
            const float* lg = IN(29) + (size_t)(layer * 2 + (tail == 3 ? 1 : 0)) * 2048; const float* lb = IN(30) + (size_t)(layer * 2 + (tail == 3 ? 1 : 0)) * 2048;
            if (tail == 0) {
                transpose_w(IN(31) + (size_t)layer * 2048 * 8192, 2048, 8192, (bf16_t*)(ws + WS_MLPW), 2048, 8192, 0, nullptr, scr, gw, NGW, lane);
                transpose_w(IN(32) + (size_t)layer * 8192 * 2048, 8192, 2048, (bf16_t*)(ws + WS_MLPW + 32 * MiB), 8192, 2048, 0, nullptr, scr, gw, NGW, lane);
            }
            if (layer == 0 && tail == 3) {
                for (int row = gw * 4; row < M; row += NGW * 4) ln_mix_rows4(Yb + (size_t)row * 2048, row, lg, lb, IN(7), (bf16_t*)(ar + AR_X6), stats + 2 * (size_t)row, lane);
            } else {
                for (int row = gw * 4; row < M; row += NGW * 4) ln_rows4(Yb + (size_t)row * 2048, lg, lb, hout + (size_t)row * 2048, HB + (size_t)row * 2048, stats + 2 * (size_t)row, layer == 3 && tail == 3, lane);
            }
        } else if (tail == 1) {
            g0 = pg8::Gemm{HB, (const bf16_t*)(ws + WS_MLPW), M, FF, 2048, 2048, 2048, 1 << 20, 0}; e0.mode = EM_RELU2; e0.o0 = (bf16_t*)(ar + AR_HID); e0.ldc = FF; ng = 1;
        } else if (tail == 2) {
            g0 = pg8::Gemm{(const bf16_t*)(ar + AR_HID), (const bf16_t*)(ws + WS_MLPW + 32 * MiB), M, 2048, FF, FF, FF, 1 << 20, 0}; e0.mode = EM_RESID; e0.res = Yb; e0.outf = Yb; e0.f0 = stats; e0.p0 = IN(29) + (size_t)(layer * 2) * 2048; e0.p1 = IN(30) + (size_t)(layer * 2) * 2048; e0.ldc = 2048; ng = 1;
        } else if (kind == 0) {
            const int j = layer == 0 ? 0 : 1; unsigned char* wb = ws + WS_MLA_W + (size_t)j * 20 * MiB;
            bf16_t* LAT = (bf16_t*)(ar + AR_LAT); float* PART = (float*)(ar + AR_PART); bf16_t* KROPE = (bf16_t*)(ar + AR_KROPE); bf16_t* Qb = (bf16_t*)(ar + AR_Q);
            bf16_t* KN = (bf16_t*)(ar + AR_KN); bf16_t* VT = (bf16_t*)(ar + AR_VT); bf16_t* Ob = (bf16_t*)(ar + AR_O);
            if (sub == 0) { g0 = pg8::Gemm{HB, (const bf16_t*)wb, M, 1280, 2048, 2048, 2048, 1 << 20, 0}; e0.mode = EM_MLA_IN; e0.o0 = LAT; e0.f0 = PART; e0.o1 = KROPE; e0.tab = tab; ng = 1; }
            else if (sub == 1) { g0 = pg8::Gemm{LAT, (const bf16_t*)(wb + 5 * MiB), M, 3072, 512, 1024, 512, 1 << 20, 0}; e0.mode = EM_MLA_Q; e0.o0 = Qb; e0.f0 = PART; e0.tab = tab; ng = 1; }
            else if (sub == 2) { g0 = pg8::Gemm{LAT + 512, (const bf16_t*)(wb + 8 * MiB), M, 4096, 512, 1024, 512, 1 << 20, 0}; e0.mode = EM_MLA_KV; e0.o0 = KN; e0.o1 = VT; e0.f0 = PART; ng = 1; }
            else if (sub == 3) {
#ifndef NO_MLA
                mla_attn_phase(lds, Qb, KN, KROPE, VT, Ob, G, bx, tid);
#endif
            }
            else { g0 = pg8::Gemm{Ob, (const bf16_t*)(wb + 12 * MiB), M, 2048, 2048, 2048, 2048, 1 << 20, 0}; e0.mode = EM_RESID; e0.res = hres; e0.outf = Yb; e0.f0 = stats; e0.p0 = rg; e0.p1 = rb; e0.ldc = 2048; ng = 1; }
        } else if (kind == 1) {
            bf16_t* X6 = (bf16_t*)(ar + AR_X6); bf16_t* RKV = (bf16_t*)(ar + AR_RKV); bf16_t* LH = (bf16_t*)(ar + AR_LH);
            float* DEC = (float*)(ar + AR_DEC); float* AF = (float*)(ar + AR_AF); bf16_t* GB = (bf16_t*)(ar + AR_GB); bf16_t* YG = (bf16_t*)(ar + AR_YG);
            unsigned char* wb = ws + WS_RW_W;
            if (sub == 0) { g0 = pg8::Gemm{X6, (const bf16_t*)wb, M, 6144, 2048, 2048, 2048, 8, SLOT}; e0.mode = EM_SPLIT; e0.o0 = RKV; ng = 1; }
            else if (sub == 1) { g0 = pg8::Gemm{X6 + 3 * (SLOT / 2), (const bf16_t*)(wb + 24 * MiB), M, 768, 2048, 2048, 2048, 1, SLOT}; e0.mode = EM_LORA_DOWN; e0.o0 = LH; ng = 1; }
            else if (sub == 2) { g0 = pg8::Gemm{LH, (const bf16_t*)(wb + 27 * MiB), M, 6144, 256, 768, 256, 8, 512}; e0.mode = EM_LORA_UP; e0.f0 = DEC; e0.f1 = AF; e0.o0 = GB; e0.p0 = IN(9); e0.p1 = IN(12); ng = 1; }
            else if (sub == 3) {
#ifndef NO_SCAN
                if (G == 256) rwkv_scan_phase(lds, RKV, DEC, AF, IN(17), IN(18), IN(19), (float*)(ar + AR_BON), hout, bx, tid);
#endif
            }
            else if (sub == 4) { rwkv_gn_phase(hout, RKV + 2 * (SLOT / 2), (const float*)(ar + AR_BON), GB, IN(20), IN(21), YG, gw, NGW, lane); }
            else { g0 = pg8::Gemm{YG, (const bf16_t*)(wb + 30 * MiB), M, 2048, 2048, 2048, 2048, 1 << 20, 0}; e0.mode = EM_RESID; e0.res = hres; e0.outf = Yb; e0.f0 = stats; e0.p0 = rg; e0.p1 = rb; e0.ldc = 2048; ng = 1; }
        } else {
            bf16_t* SQ = (bf16_t*)(ar + AR_SQ); bf16_t* SK = (bf16_t*)(ar + AR_SK); bf16_t* SVT = (bf16_t*)(ar + AR_SVT); bf16_t* SO = (bf16_t*)(ar + AR_SO);
            unsigned char* wb = ws + WS_SW_W;
            if (sub == 0) { g0 = pg8::Gemm{HB, (const bf16_t*)wb, M, 2560, 2048, 2048, 2048, 1 << 20, 0}; e0.mode = EM_SWA_QKV; e0.o0 = SQ; e0.o1 = SK; e0.o2 = SVT; e0.bias = IN(24); ng = 1; }
            else if (sub == 1) {
#ifndef NO_SWA
                swa_attn_phase(lds, SQ, SK, SVT, SO, bt2, IN(25), G, bx, tid);
#endif
            }
            else { g0 = pg8::Gemm{SO, (const bf16_t*)(wb + 10 * MiB), M, 2048, 2048, 2048, 2048, 1 << 20, 0}; e0.mode = EM_RESID; e0.res = hres; e0.outf = Yb; e0.f0 = stats; e0.p0 = rg; e0.p1 = rb; e0.bias = IN(27); e0.ldc = 2048; ng = 1; }
        }
#ifndef NO_GEMM
        if (ng) { pg8::StaticOrder S; S.init(g0.M, g0.N, G, bx); pg8::gemm_phase<EpiP>(lds, g0, S, e0, tid); }
#endif
    }
}

extern "C" void kernel_launch(void* const* d_in, const int* in_sizes, int n_in, void* d_out, int out_size, void* d_ws, size_t ws_size, hipStream_t stream) {
    static int grid = 0;
    if (grid == 0) {
        if (n_in != 33 || out_size != M * DM || ws_size < WS_END) { fprintf(stderr, "kernel_launch: unexpected problem (n_in %d, out %d, ws %zu < %zu)\n", n_in, out_size, ws_size, (size_t)WS_END); grid = -1; return; }
        int dev = 0, cus = 0, per_cu = 0;
        hipGetDevice(&dev); hipDeviceGetAttribute(&cus, hipDeviceAttributeMultiprocessorCount, dev);
        if (hipFuncSetAttribute((const void*)hybrid_fwd, hipFuncAttributeMaxDynamicSharedMemorySize, LDS_BYTES) != hipSuccess) { fprintf(stderr, "kernel_launch: hipFuncSetAttribute failed\n"); grid = -1; return; }
        if (hipOccupancyMaxActiveBlocksPerMultiprocessor(&per_cu, (const void*)hybrid_fwd, 512, LDS_BYTES) != hipSuccess || per_cu < 1) { fprintf(stderr, "kernel_launch: occupancy query says %d\n", per_cu); per_cu = 1; }
        (void)hipGetLastError();
        grid = cus;
        fprintf(stderr, "kernel_launch: grid %d (cus %d, per_cu %d)\n", grid, cus, per_cu);
    }
    if (grid < 0) return;
    Args a{};
    for (int i = 0; i < 33; ++i) a.in[i] = (const float*)d_in[i];
    a.out = (float*)d_out; a.ws = (unsigned char*)d_ws;
#ifndef MK_PER_PHASE
    a.ph_lo = 0; a.ph_hi = N_PHASES;
    if (hipMemsetAsync((char*)d_ws + WS_BAR, 0, WS_BAR_BYTES, stream) != hipSuccess) { fprintf(stderr, "kernel_launch: memset of the barrier words failed\n"); return; }
    void* kargs[] = {&a};
    hipError_t e = hipLaunchCooperativeKernel((const void*)hybrid_fwd, dim3(grid), dim3(512), kargs, LDS_BYTES, stream);
    if (e != hipSuccess) fprintf(stderr, "cooperative launch failed: %s (grid %d)\n", hipGetErrorString(e), grid);
#else
    for (int ph = 0; ph < N_PHASES; ++ph) { a.ph_lo = ph; a.ph_hi = ph + 1; hipLaunchKernelGGL(hybrid_fwd, dim3(grid), dim3(512), LDS_BYTES, stream, a); }
#endif
}
```

```cpp
#include <hip/hip_runtime.h>
#include <hip/hip_cooperative_groups.h>
#include <cstdio>
#include <cstdint>
namespace cg = cooperative_groups;

#define GAS __attribute__((address_space(1)))
#define LAS __attribute__((address_space(3)))
typedef unsigned short bf16_t;
typedef short bf16x8 __attribute__((ext_vector_type(8)));
typedef float f32x4 __attribute__((ext_vector_type(4)));
typedef float f32x2 __attribute__((ext_vector_type(2)));
typedef float f32x16 __attribute__((ext_vector_type(16)));
typedef unsigned u32x4 __attribute__((ext_vector_type(4)));
typedef unsigned u32x2 __attribute__((ext_vector_type(2)));

constexpr int M = 16384, DM = 2048, SEQ = 8192, FF = 8192;
constexpr float ALPHA = 1.6817928305074290f;
constexpr float LOG2E = 1.4426950408889634f;
constexpr size_t MiB = 1u << 20;
constexpr size_t WS_TAB = 0;
constexpr size_t WS_BT = 2 * MiB;
constexpr size_t WS_STATS = 3 * MiB;
constexpr size_t WS_BAR = 3 * MiB + 512 * 1024;
constexpr size_t WS_BAR_BYTES = 16384;
constexpr size_t WS_MLA_W = 4 * MiB;
constexpr size_t WS_RW_W = 44 * MiB;
constexpr size_t WS_SW_W = 82 * MiB;
constexpr size_t WS_MLPW = 100 * MiB;
constexpr size_t WS_HB = 164 * MiB;
constexpr size_t WS_Y = 228 * MiB;
constexpr size_t WS_AR = 356 * MiB;
constexpr size_t WS_END = WS_AR + 602 * MiB;
constexpr size_t AR_HID = 0;
constexpr size_t AR_LAT = 0, AR_PART = 32 * MiB, AR_KROPE = 33 * MiB, AR_Q = 36 * MiB, AR_KN = 132 * MiB, AR_VT = 196 * MiB, AR_O = 260 * MiB;
constexpr size_t AR_BON = 600 * MiB;
constexpr size_t AR_X6 = 0, AR_RKV = 384 * MiB, AR_LH = 576 * MiB, AR_DEC = 0, AR_AF = 128 * MiB, AR_GB = 256 * MiB, AR_YG = 320 * MiB;
constexpr size_t AR_SQ = 0, AR_SK = 64 * MiB, AR_SVT = 72 * MiB, AR_SO = 80 * MiB;
constexpr size_t SLOT = (size_t)M * DM * 2;

constexpr int LDS_BYTES = 131072 + 4096;

__device__ __forceinline__ unsigned cvt_pk_bf16(float lo, float hi) { unsigned r; asm volatile("v_cvt_pk_bf16_f32 %0, %1, %2" : "=v"(r) : "v"(lo), "v"(hi)); return r; }
__device__ __forceinline__ float bf2f(unsigned short b) { return __builtin_bit_cast(float, (unsigned)b << 16); }
__device__ __forceinline__ float bflo(unsigned w) { return __builtin_bit_cast(float, w << 16); }
__device__ __forceinline__ float bfhi(unsigned w) { return __builtin_bit_cast(float, w & 0xffff0000u); }
__device__ __forceinline__ u32x4 pack8(f32x4 a, f32x4 b) { u32x4 w; w.x = cvt_pk_bf16(a[0], a[1]); w.y = cvt_pk_bf16(a[2], a[3]); w.z = cvt_pk_bf16(b[0], b[1]); w.w = cvt_pk_bf16(b[2], b[3]); return w; }
__device__ __forceinline__ float wave_sum(float v) {
#pragma unroll
    for (int o = 1; o < 64; o <<= 1) v += __shfl_xor(v, o);
    return v;
}
template <int CTRL> __device__ __forceinline__ float dpp_f(float x) { return __builtin_bit_cast(float, __builtin_amdgcn_update_dpp(0, __builtin_bit_cast(int, x), CTRL, 0xF, 0xF, true)); }
__device__ __forceinline__ float sum16(float x) { x += dpp_f<0xB1>(x); x += dpp_f<0x4E>(x); x += dpp_f<0x141>(x); x += dpp_f<0x140>(x); return x; }
__device__ __forceinline__ float sigmoidf_(float x) { return 1.0f / (1.0f + __expf(-x)); }
__device__ __forceinline__ int crow(int r, int hi) { return (r & 3) + 8 * (r >> 2) + 4 * hi; }

namespace pg8 {
constexpr int BM = 256, BK = 64, HALF = 128, HTB = HALF * BK * 2, STAGE_BYTES = 8 * HTB, NXCD = 8, WGM = 4;
__host__ __device__ __forceinline__ int lds_byte(int r, int c) { const int st = (r >> 4) * 2 + (c >> 5), rr = r & 15, cc = c & 31, ob = rr * 64 + cc * 2; return st * 1024 + (ob ^ (((ob >> 9) & 1) << 5)); }
__host__ __device__ __forceinline__ void stage_rc(int b, int& R, int& C) { const int st = b / 1024, sb = b % 1024, swz = sb ^ (((sb >> 9) & 1) << 5); R = (st >> 1) * 16 + swz / 64; C = (st & 1) * 32 + (swz % 64) / 2; }
__host__ __device__ __forceinline__ int perm32(int rho) { const int n = rho >> 4, i = rho & 15; return 8 * (i >> 2) + 4 * n + (i & 3); }

struct Unit { int pm, pn; };
struct Gemm { const bf16_t* A; const bf16_t* Bt; int M, N, K, lda, ldb, a_group; size_t a_stride; };

struct StaticOrder {
    int nM, nN, nwg, G, c;
    __device__ void init(int M_, int N_, int G_, int c_) { nM = M_ / BM; nN = N_ / BM; nwg = nM * nN; G = G_; c = c_; }
    __device__ bool next(int i, Unit& u) const {
        const long L = (long)i * G + c; if (L >= nwg) return false;
        int wgid = (int)L; { const int q = nwg / NXCD, r = nwg % NXCD, xcd = wgid % NXCD, off = wgid / NXCD; wgid = (xcd < r ? xcd * (q + 1) : r * (q + 1) + (xcd - r) * q) + off; }
        const int wgm = (nN >= 16) ? 8 : 4;
        const int nig = wgm * nN, gid = wgid / nig, fm = gid * wgm, gsz = (nM - fm) < wgm ? (nM - fm) : wgm;
        u.pm = fm + ((wgid % nig) % gsz); u.pn = (wgid % nig) / gsz; return true;
    }
};

template <class Epi>
__device__ __forceinline__ void gemm_phase(LAS unsigned char* lds, const Gemm g, const StaticOrder& S, const Epi& E, const int tid) {
    const int wid = __builtin_amdgcn_readfirstlane(tid >> 6), lane = tid & 63, wr = wid >> 2, wc = wid & 3, fr = lane & 15, fq = lane >> 4;
    const int K = g.K, nt = K / BK;
    unsigned voffA[2], voffB[2];
#pragma unroll
    for (int i = 0; i < 2; ++i) { int R, C; stage_rc(tid * 16 + i * 8192, R, C); const int Rb = (R & ~31) + perm32(R & 31);
        voffA[i] = (unsigned)(R * g.lda + C) * 2u; voffB[i] = (unsigned)(Rb * g.ldb + C) * 2u; }
    const size_t kstep = (size_t)(BK * 2);
    const size_t hstepA = (size_t)HALF * g.lda * 2, hstepB = (size_t)HALF * g.ldb * 2;
    const size_t tstepA = 2 * hstepA, tstepB = 2 * hstepB;
    const unsigned ldsw = (unsigned)wid * 1024u;
    const int aoff = lds_byte(wr * 64 + fr, fq * 8), boff = lds_byte(wc * 32 + fr, fq * 8);
#define PG8_SA(b, h) (((b) * 2 + (h)) * HTB)
#define PG8_SB(b, h) ((4 + (b) * 2 + (h)) * HTB)
#define PG8_STAGE(bufoff, gbase, voff) do { _Pragma("unroll") for (int _i = 0; _i < 2; ++_i) \
        __builtin_amdgcn_global_load_lds((const unsigned*)((const char*)(gbase) + (voff)[_i]), (LAS unsigned*)(lds + (bufoff) + ldsw + _i * 8192), 16, 0, 0); } while (0)
#define PG8_LDA(dst, b, h) do { _Pragma("unroll") for (int m = 0; m < 4; ++m) _Pragma("unroll") for (int k = 0; k < 2; ++k) dst[m][k] = *(const LAS bf16x8*)(lds + PG8_SA(b, h) + aoff + m * 2048 + k * 1024); } while (0)
#define PG8_LDB(dst, b, h) do { _Pragma("unroll") for (int n = 0; n < 2; ++n) _Pragma("unroll") for (int k = 0; k < 2; ++k) dst[n][k] = *(const LAS bf16x8*)(lds + PG8_SB(b, h) + boff + n * 2048 + k * 1024); } while (0)
#define PG8_MMA(ai, bj, At, Bt) do { __builtin_amdgcn_s_setprio(1); _Pragma("unroll") for (int m = 0; m < 4; ++m) _Pragma("unroll") for (int n = 0; n < 2; ++n) _Pragma("unroll") for (int k = 0; k < 2; ++k) \
        acc[ai][bj][m][n] = __builtin_amdgcn_mfma_f32_16x16x32_bf16(Bt[n][k], At[m][k], acc[ai][bj][m][n], 0, 0, 0); __builtin_amdgcn_s_setprio(0); } while (0)
#define PG8_WAIT_V(n) asm volatile("s_waitcnt vmcnt(" #n ")" ::: "memory")
#define PG8_WAIT_L(n) asm volatile("s_waitcnt lgkmcnt(" #n ")" ::: "memory")
#define PG8_BAR __builtin_amdgcn_s_barrier()
#define PG8_SCHED __builtin_amdgcn_sched_barrier(0)
    Unit cur, nxt; int ui = 0;
    if (!S.next(0, cur)) return;
    f32x4 acc[2][2][4][2];
#pragma unroll
    for (int a = 0; a < 2; ++a)
#pragma unroll
        for (int b = 0; b < 2; ++b)
#pragma unroll
            for (int m = 0; m < 4; ++m)
#pragma unroll
                for (int n = 0; n < 2; ++n) acc[a][b][m][n] = (f32x4){0.f, 0.f, 0.f, 0.f};
    bf16x8 At[4][2], B0[2][2], B1[2][2];
    const char* cA = (const char*)g.A + (size_t)cur.pm * tstepA + (size_t)(cur.pn / g.a_group) * g.a_stride; const char* cB = (const char*)g.Bt + (size_t)cur.pn * tstepB;
    PG8_STAGE(PG8_SB(0, 0), cB, voffB); PG8_STAGE(PG8_SB(0, 1), cB + hstepB, voffB); PG8_STAGE(PG8_SA(0, 0), cA, voffA); PG8_STAGE(PG8_SA(0, 1), cA + hstepA, voffA);
    if (wr == 1) PG8_BAR;
    PG8_WAIT_V(2); PG8_BAR;
    PG8_STAGE(PG8_SB(1, 0), cB + kstep, voffB); PG8_STAGE(PG8_SA(1, 0), cA + kstep, voffA); PG8_STAGE(PG8_SB(1, 1), cB + hstepB + kstep, voffB);
    PG8_WAIT_V(6); PG8_BAR;
    for (;;) {
        const bool has_next = S.next(ui + 1, nxt);
        const char* nA = has_next ? (const char*)g.A + (size_t)nxt.pm * tstepA + (size_t)(nxt.pn / g.a_group) * g.a_stride : cA; const char* nB = has_next ? (const char*)g.Bt + (size_t)nxt.pn * tstepB : cB;
        for (int t = 0; t < nt; t += 2) {
            const bool last = (t == nt - 2);
            const char* a1 = cA + (size_t)(t + 1) * kstep;
            const char* a2 = last ? nA : cA + (size_t)(t + 2) * kstep; const char* b2 = last ? nB : cB + (size_t)(t + 2) * kstep;
            const char* a3 = a2 + kstep; const char* b3 = b2 + kstep;
            PG8_LDB(B0, 0, 0); PG8_LDB(B1, 0, 1); PG8_SCHED; PG8_LDA(At, 0, 0); PG8_STAGE(PG8_SA(1, 1), a1 + hstepA, voffA);
            PG8_WAIT_V(8); PG8_WAIT_L(0); PG8_BAR; PG8_MMA(0, 0, At, B0); PG8_MMA(0, 1, At, B1); PG8_BAR; PG8_SCHED;
            PG8_LDA(At, 0, 1); PG8_STAGE(PG8_SB(0, 0), b2, voffB); PG8_STAGE(PG8_SB(0, 1), b2 + hstepB, voffB); PG8_STAGE(PG8_SA(0, 0), a2, voffA);
            PG8_WAIT_V(8); PG8_WAIT_L(0); PG8_BAR; PG8_MMA(1, 0, At, B0); PG8_MMA(1, 1, At, B1); PG8_BAR; PG8_SCHED;
            PG8_LDB(B0, 1, 0); PG8_LDB(B1, 1, 1); PG8_SCHED; PG8_LDA(At, 1, 0); PG8_STAGE(PG8_SA(0, 1), a2 + hstepA, voffA);
            PG8_WAIT_V(8); PG8_WAIT_L(0); PG8_BAR; PG8_MMA(0, 0, At, B0); PG8_MMA(0, 1, At, B1); PG8_BAR; PG8_SCHED;
            PG8_LDA(At, 1, 1); PG8_STAGE(PG8_SB(1, 0), b3, voffB); PG8_STAGE(PG8_SB(1, 1), b3 + hstepB, voffB); PG8_STAGE(PG8_SA(1, 0), a3, voffA);
            PG8_WAIT_V(8); PG8_WAIT_L(0); PG8_BAR; PG8_MMA(1, 0, At, B0); PG8_MMA(1, 1, At, B1); PG8_BAR; PG8_SCHED;
        }
        if (wr == 0) PG8_BAR;
        E(acc, cur, wr, wc, fr, fq);
        if (!has_next) break;
#pragma unroll
        for (int a = 0; a < 2; ++a)
#pragma unroll
            for (int b = 0; b < 2; ++b)
#pragma unroll
                for (int m = 0; m < 4; ++m)
#pragma unroll
                    for (int n = 0; n < 2; ++n) acc[a][b][m][n] = (f32x4){0.f, 0.f, 0.f, 0.f};
        cur = nxt; cA = nA; cB = nB; ++ui;
        if (wr == 1) PG8_BAR;
    }
    PG8_WAIT_V(0);
    PG8_BAR;
#undef PG8_SA
#undef PG8_SB
#undef PG8_STAGE
#undef PG8_LDA
#undef PG8_LDB
#undef PG8_MMA
#undef PG8_WAIT_V
#undef PG8_WAIT_L
#undef PG8_BAR
#undef PG8_SCHED
}
}

enum EpiMode { EM_RESID = 0, EM_RELU2, EM_SPLIT, EM_LORA_DOWN, EM_LORA_UP, EM_SWA_QKV, EM_MLA_IN, EM_MLA_Q, EM_MLA_KV };
struct EpiP {
    int mode;
    const float* res; const float* bias; float* outf;
    bf16_t* o0; bf16_t* o1; bf16_t* o2;
    float* f0; float* f1;
    const float* p0; const float* p1;
    const float* tab;
    int ldc;
    __device__ __forceinline__ void operator()(const f32x4 (&acc)[2][2][4][2], const pg8::Unit& u, int wr, int wc, int fr, int fq) const {
        const int row0 = u.pm * 256 + wr * 64 + fr, colb = u.pn * 256 + wc * 32 + 8 * fq;
#define EPI_BEGIN _Pragma("unroll") for (int ai = 0; ai < 2; ++ai) _Pragma("unroll") for (int m = 0; m < 4; ++m) { const int row = row0 + ai * 128 + m * 16; \
        _Pragma("unroll") for (int bj = 0; bj < 2; ++bj) { const int col = colb + bj * 128; f32x4 v0 = acc[ai][bj][m][0], v1 = acc[ai][bj][m][1];
#define EPI_END } asm volatile("" ::: "memory"); }
        if (mode == EM_RESID) {
            EPI_BEGIN { const size_t off = (size_t)row * ldc + col; f32x4 r0 = *(const f32x4*)(res + off), r1 = *(const f32x4*)(res + off + 4);
                if (p0) { const f32x2 ms = *(const f32x2*)(f0 + 2 * (size_t)row); const f32x4 g0 = *(const f32x4*)(p0 + col), g1 = *(const f32x4*)(p0 + col + 4), b0 = *(const f32x4*)(p1 + col), b1 = *(const f32x4*)(p1 + col + 4);
                    r0 = (r0 - ms[0]) * ms[1] * g0 + b0; r1 = (r1 - ms[0]) * ms[1] * g1 + b1; }
                if (bias) { v0 += *(const f32x4*)(bias + col); v1 += *(const f32x4*)(bias + col + 4); }
                *(f32x4*)(outf + off) = r0 * ALPHA + v0; *(f32x4*)(outf + off + 4) = r1 * ALPHA + v1; } EPI_END
        } else if (mode == EM_RELU2) {
            EPI_BEGIN { const f32x4 z = {0.f, 0.f, 0.f, 0.f}; v0 = __builtin_elementwise_max(v0, z); v1 = __builtin_elementwise_max(v1, z); v0 = v0 * v0; v1 = v1 * v1;
                *(u32x4*)(o0 + (size_t)row * ldc + col) = pack8(v0, v1); } EPI_END
        } else if (mode == EM_SPLIT) {
            EPI_BEGIN { const int s = col >> 11, c = col & 2047; *(u32x4*)(o0 + (size_t)s * (SLOT / 2) + (size_t)row * 2048 + c) = pack8(v0, v1); } EPI_END
        } else if (mode == EM_LORA_DOWN) {
            const int pn = u.pn;
            EPI_BEGIN {
                if (pn == 0) {
#pragma unroll
                    for (int e = 0; e < 4; ++e) { v0[e] = 1.0f - 2.0f / (1.0f + __expf(2.0f * v0[e])); v1[e] = 1.0f - 2.0f / (1.0f + __expf(2.0f * v1[e])); }
                } else if (pn == 2) {
#pragma unroll
                    for (int e = 0; e < 4; ++e) { v0[e] = sigmoidf_(v0[e]); v1[e] = sigmoidf_(v1[e]); }
                }
                *(u32x4*)(o0 + (size_t)row * 768 + col) = pack8(v0, v1); } EPI_END
        } else if (mode == EM_LORA_UP) {
            const int grp = u.pn >> 3;
            EPI_BEGIN { const int c = col & 2047; const size_t off = (size_t)row * 2048 + c;
                if (grp == 0) { const f32x4 b0 = *(const f32x4*)(p0 + c), b1 = *(const f32x4*)(p0 + c + 4);
#pragma unroll
                    for (int e = 0; e < 4; ++e) { v0[e] = __expf(-0.6065306597126334f * sigmoidf_(v0[e] + b0[e])); v1[e] = __expf(-0.6065306597126334f * sigmoidf_(v1[e] + b1[e])); }
                    *(f32x4*)(f0 + off) = v0; *(f32x4*)(f0 + off + 4) = v1;
                } else if (grp == 1) { const f32x4 b0 = *(const f32x4*)(p1 + c), b1 = *(const f32x4*)(p1 + c + 4);
#pragma unroll
                    for (int e = 0; e < 4; ++e) { v0[e] = sigmoidf_(v0[e] + b0[e]); v1[e] = sigmoidf_(v1[e] + b1[e]); }
                    *(f32x4*)(f1 + off) = v0; *(f32x4*)(f1 + off + 4) = v1;
                } else { *(u32x4*)(o0 + off) = pack8(v0, v1); } } EPI_END
        } else if (mode == EM_SWA_QKV) {
            const float qs = 0.125f * LOG2E;
            EPI_BEGIN { v0 += *(const f32x4*)(bias + col); v1 += *(const f32x4*)(bias + col + 4);
                if (col < 2048) { *(u32x4*)(o0 + (size_t)row * 2048 + col) = pack8(v0 * qs, v1 * qs); }
                else if (col < 2304) { *(u32x4*)(o1 + (size_t)row * 256 + (col - 2048)) = pack8(v0, v1); }
                else { const int d = col - 2304, b = row >> 13, t = row & 8191; bf16_t* vp = o2 + ((size_t)(b * 256 + d)) * 8192 + t; const u32x4 w = pack8(v0, v1);
                    vp[0] = (bf16_t)(w.x & 0xffff); vp[8192] = (bf16_t)(w.x >> 16); vp[2 * 8192] = (bf16_t)(w.y & 0xffff); vp[3 * 8192] = (bf16_t)(w.y >> 16);
                    vp[4 * 8192] = (bf16_t)(w.z & 0xffff); vp[5 * 8192] = (bf16_t)(w.z >> 16); vp[6 * 8192] = (bf16_t)(w.w & 0xffff); vp[7 * 8192] = (bf16_t)(w.w >> 16); } } EPI_END
        } else if (mode == EM_MLA_IN) {
            const int pn = u.pn;
#pragma unroll
            for (int ai = 0; ai < 2; ++ai)
#pragma unroll
                for (int m = 0; m < 4; ++m) { const int row = row0 + ai * 128 + m * 16;
                    if (pn < 4) { float ss = 0.f;
#pragma unroll
                        for (int bj = 0; bj < 2; ++bj) { const int col = colb + bj * 128; const f32x4 v0 = acc[ai][bj][m][0], v1 = acc[ai][bj][m][1];
                            ss += (v0[0] * v0[0] + v0[1] * v0[1]) + (v0[2] * v0[2] + v0[3] * v0[3]) + (v1[0] * v1[0] + v1[1] * v1[1]) + (v1[2] * v1[2] + v1[3] * v1[3]);
                            *(u32x4*)(o0 + (size_t)row * 1024 + col) = pack8(v0, v1); }
                        ss += __shfl_xor(ss, 16); ss += __shfl_xor(ss, 32);
                        if (fq == 0) f0[(size_t)row * 16 + pn * 4 + wc] = ss;
                    } else if (wc < 2) {
                        const f32x4 v0 = acc[ai][0][m][0], v1 = acc[ai][0][m][1]; const int pos = row & 8191, i0 = 16 * wc + 4 * fq;
                        const f32x4 t0 = *(const f32x4*)(tab + ((size_t)pos * 32 + i0) * 2), t1 = *(const f32x4*)(tab + ((size_t)pos * 32 + i0) * 2 + 4);
                        const float a0 = v0[0] * t0[0] - v0[1] * t0[1], b0 = v0[1] * t0[0] + v0[0] * t0[1];
                        const float a1 = v0[2] * t0[2] - v0[3] * t0[3], b1 = v0[3] * t0[2] + v0[2] * t0[3];
                        const float a2 = v1[0] * t1[0] - v1[1] * t1[1], b2 = v1[1] * t1[0] + v1[0] * t1[1];
                        const float a3 = v1[2] * t1[2] - v1[3] * t1[3], b3 = v1[3] * t1[2] + v1[2] * t1[3];
                        u32x2 wa, wb; wa.x = cvt_pk_bf16(a0, a1); wa.y = cvt_pk_bf16(a2, a3); wb.x = cvt_pk_bf16(b0, b1); wb.y = cvt_pk_bf16(b2, b3);
                        *(u32x2*)(o1 + (size_t)row * 64 + i0) = wa; *(u32x2*)(o1 + (size_t)row * 64 + 32 + i0) = wb; }
                    asm volatile("" ::: "memory");
                }
        } else if (mode == EM_MLA_Q) {
            const int pn = u.pn; const float qsc = 0.07216878364870322f * LOG2E;
#pragma unroll
            for (int ai = 0; ai < 2; ++ai)
#pragma unroll
                for (int m = 0; m < 4; ++m) { const int row = row0 + ai * 128 + m * 16;
                    const f32x4 pa = *(const f32x4*)(f0 + (size_t)row * 16), pb = *(const f32x4*)(f0 + (size_t)row * 16 + 4);
                    const float ssq = ((pa[0] + pa[1]) + (pa[2] + pa[3])) + ((pb[0] + pb[1]) + (pb[2] + pb[3]));
                    const float sc = qsc / sqrtf(ssq * (1.0f / 512.0f) + 1e-6f);
#pragma unroll
                    for (int bj = 0; bj < 2; ++bj) { const int col = colb + bj * 128; const f32x4 v0 = acc[ai][bj][m][0] * sc, v1 = acc[ai][bj][m][1] * sc;
                        if (pn < 8) { const int h = col >> 7, d = col & 127; *(u32x4*)(o0 + (size_t)row * 3072 + h * 192 + d) = pack8(v0, v1); }
                        else { const int j = col - 2048, h = j >> 6, i0 = (j & 63) >> 1, pos = row & 8191;
                            const f32x4 t0 = *(const f32x4*)(tab + ((size_t)pos * 32 + i0) * 2), t1 = *(const f32x4*)(tab + ((size_t)pos * 32 + i0) * 2 + 4);
                            const float a0 = v0[0] * t0[0] - v0[1] * t0[1], b0 = v0[1] * t0[0] + v0[0] * t0[1];
                            const float a1 = v0[2] * t0[2] - v0[3] * t0[3], b1 = v0[3] * t0[2] + v0[2] * t0[3];
                            const float a2 = v1[0] * t1[0] - v1[1] * t1[1], b2 = v1[1] * t1[0] + v1[0] * t1[1];
                            const float a3 = v1[2] * t1[2] - v1[3] * t1[3], b3 = v1[3] * t1[2] + v1[2] * t1[3];
                            u32x2 wa, wb; wa.x = cvt_pk_bf16(a0, a1); wa.y = cvt_pk_bf16(a2, a3); wb.x = cvt_pk_bf16(b0, b1); wb.y = cvt_pk_bf16(b2, b3);
                            bf16_t* qp = o0 + (size_t)row * 3072 + h * 192 + 128 + i0; *(u32x2*)qp = wa; *(u32x2*)(qp + 32) = wb; } }
                    asm volatile("" ::: "memory");
                }
        } else {
            const int h = u.pn;
#pragma unroll
            for (int ai = 0; ai < 2; ++ai)
#pragma unroll
                for (int m = 0; m < 4; ++m) { const int row = row0 + ai * 128 + m * 16;
                    const f32x4 pa = *(const f32x4*)(f0 + (size_t)row * 16 + 8), pb = *(const f32x4*)(f0 + (size_t)row * 16 + 12);
                    const float ssq = ((pa[0] + pa[1]) + (pa[2] + pa[3])) + ((pb[0] + pb[1]) + (pb[2] + pb[3]));
                    const float sc = 1.0f / sqrtf(ssq * (1.0f / 512.0f) + 1e-6f);
                    { const f32x4 v0 = acc[ai][0][m][0] * sc, v1 = acc[ai][0][m][1] * sc; *(u32x4*)(o0 + (size_t)row * 2048 + h * 128 + wc * 32 + 8 * fq) = pack8(v0, v1); }
                    { const f32x4 v0 = acc[ai][1][m][0] * sc, v1 = acc[ai][1][m][1] * sc; const int b = row >> 13, t = row & 8191, dv = wc * 32 + 8 * fq;
                        bf16_t* vp = o1 + ((size_t)((b * 16 + h) * 128 + dv)) * 8192 + t; const u32x4 w = pack8(v0, v1);
                        vp[0] = (bf16_t)(w.x & 0xffff); vp[8192] = (bf16_t)(w.x >> 16); vp[2 * 8192] = (bf16_t)(w.y & 0xffff); vp[3 * 8192] = (bf16_t)(w.y >> 16);
                        vp[4 * 8192] = (bf16_t)(w.z & 0xffff); vp[5 * 8192] = (bf16_t)(w.z >> 16); vp[6 * 8192] = (bf16_t)(w.w & 0xffff); vp[7 * 8192] = (bf16_t)(w.w >> 16); }
                    asm volatile("" ::: "memory");
                }
        }
#undef EPI_BEGIN
#undef EPI_END
    }
};

__device__ __forceinline__ int colmap(int kind, int n, int Nsrc) {
    if (kind == 1) { if (n < 1024) return n; if (n >= 1088) return -1; const int j = n - 1024; return 1024 + (j >> 1) + 32 * (j & 1); }
    if (kind == 2) { if (n < 2048) return (n >> 7) * 192 + (n & 127); const int j = n - 2048, h = j >> 6, jj = j & 63; return h * 192 + 128 + (jj >> 1) + 32 * (jj & 1); }
    return n < Nsrc ? n : -1;
}
__device__ __forceinline__ void transpose_w(const float* W, int Ksrc, int Nsrc, bf16_t* WT, int ldwt, int Ndst, int kind, const float* rscale, LAS float* scr, int gw, int NGW, int lane) {
    const int nblk = Ndst / 64, nitems = (Ksrc / 64) * nblk;
    const int nl = (lane & 15) * 4, kr = lane >> 4, c = lane & 7;
    if (kind == 0 && Ndst <= Nsrc) {
        f32x4 cur[16], nxt[16];
        int item = gw;
        if (item < nitems) { const int k0 = 64 * (item / nblk), n0 = 64 * (item % nblk);
#pragma unroll
            for (int i = 0; i < 16; ++i) cur[i] = *(const f32x4*)(W + (size_t)(k0 + 4 * i + kr) * Nsrc + n0 + nl); }
        for (; item < nitems; item += NGW) {
            const int k0 = 64 * (item / nblk), n0 = 64 * (item % nblk); const int nit = item + NGW;
            if (nit < nitems) { const int k1 = 64 * (nit / nblk), n1 = 64 * (nit % nblk);
#pragma unroll
                for (int i = 0; i < 16; ++i) nxt[i] = *(const f32x4*)(W + (size_t)(k1 + 4 * i + kr) * Nsrc + n1 + nl); }
#pragma unroll
            for (int i = 0; i < 16; ++i) { const int kk = 4 * i + kr; f32x4 v = cur[i]; if (rscale) v = v * rscale[k0 + kk];
                LAS float* d = scr + kk * 65 + nl; d[0] = v[0]; d[1] = v[1]; d[2] = v[2]; d[3] = v[3]; }
            asm volatile("s_waitcnt lgkmcnt(0)" ::: "memory");
#pragma unroll
            for (int j = 0; j < 8; ++j) { const int n = (lane >> 3) + 8 * j; const LAS float* sp = scr + (8 * c) * 65 + n;
                u32x4 o; o.x = cvt_pk_bf16(sp[0 * 65], sp[1 * 65]); o.y = cvt_pk_bf16(sp[2 * 65], sp[3 * 65]); o.z = cvt_pk_bf16(sp[4 * 65], sp[5 * 65]); o.w = cvt_pk_bf16(sp[6 * 65], sp[7 * 65]);
                *(u32x4*)(WT + (size_t)(n0 + n) * ldwt + k0 + 8 * c) = o; }
            asm volatile("s_waitcnt lgkmcnt(0)" ::: "memory");
#pragma unroll
            for (int i = 0; i < 16; ++i) cur[i] = nxt[i];
        }
        return;
    }
    for (int item = gw; item < nitems; item += NGW) {
        const int kb = item / nblk, nb = item % nblk, k0 = 64 * kb, n0 = 64 * nb;
        if (kind == 0 && n0 + 64 <= Nsrc) {
#pragma unroll 4
            for (int i = 0; i < 16; ++i) { const int kk = 4 * i + kr; f32x4 v = *(const f32x4*)(W + (size_t)(k0 + kk) * Nsrc + n0 + nl); if (rscale) v = v * rscale[k0 + kk];
                LAS float* d = scr + kk * 65 + nl; d[0] = v[0]; d[1] = v[1]; d[2] = v[2]; d[3] = v[3]; }
        } else {
            int src[4];
#pragma unroll
            for (int e = 0; e < 4; ++e) src[e] = colmap(kind, n0 + nl + e, Nsrc);
#pragma unroll 4
            for (int i = 0; i < 16; ++i) { const int kk = 4 * i + kr; const float rs = rscale ? rscale[k0 + kk] : 1.0f; LAS float* d = scr + kk * 65 + nl;
#pragma unroll
                for (int e = 0; e < 4; ++e) d[e] = (src[e] >= 0) ? W[(size_t)(k0 + kk) * Nsrc + src[e]] * rs : 0.f; }
        }
        asm volatile("s_waitcnt lgkmcnt(0)" ::: "memory");
#pragma unroll
        for (int j = 0; j < 8; ++j) { const int n = (lane >> 3) + 8 * j; const LAS float* sp = scr + (8 * c) * 65 + n;
            u32x4 o; o.x = cvt_pk_bf16(sp[0 * 65], sp[1 * 65]); o.y = cvt_pk_bf16(sp[2 * 65], sp[3 * 65]); o.z = cvt_pk_bf16(sp[4 * 65], sp[5 * 65]); o.w = cvt_pk_bf16(sp[6 * 65], sp[7 * 65]);
            *(u32x4*)(WT + (size_t)(n0 + n) * ldwt + k0 + 8 * c) = o; }
        asm volatile("s_waitcnt lgkmcnt(0)" ::: "memory");
    }
}
__device__ __forceinline__ void transpose_small(const float* W, bf16_t* WT, int gt, int NGT) {
    for (int idx = gt; idx < 2048 * 32; idx += NGT) { const int n = idx >> 5, k0 = (idx & 31) * 8; float v[8];
#pragma unroll
        for (int e = 0; e < 8; ++e) v[e] = (k0 + e < 96) ? W[(size_t)(k0 + e) * 2048 + n] : 0.f;
        u32x4 o; o.x = cvt_pk_bf16(v[0], v[1]); o.y = cvt_pk_bf16(v[2], v[3]); o.z = cvt_pk_bf16(v[4], v[5]); o.w = cvt_pk_bf16(v[6], v[7]);
        *(u32x4*)(WT + (size_t)n * 256 + k0) = o; }
}
__device__ __forceinline__ void rope_cs(int pos, int i, float& c, float& s) {
    const float fi = (float)i, ph = fi * 0.415241003036499f, pe = __builtin_fmaf(fi, 0.415241003036499f, -ph) + fi * 8.82442119376492e-09f;
    const float inv0 = __builtin_amdgcn_exp2f(-ph), inv = inv0 - inv0 * 0.69314718f * pe;
    const float fp = (float)pos, p = fp * inv, pe2 = __builtin_fmaf(fp, inv, -p);
    const float kq = __builtin_rintf(p * 0.636619772f); const int q = (int)kq;
    float r = __builtin_fmaf(-kq, 1.5707963705062866f, p); r = __builtin_fmaf(-kq, -4.371138828673793e-08f, r); r += pe2;
    const float r2 = r * r;
    float sp = 2.7557319e-06f; sp = sp * r2 - 1.9841270e-04f; sp = sp * r2 + 8.3333333e-03f; sp = sp * r2 - 1.6666667e-01f;
    const float sn = r + r * r2 * sp;
    float cp = -2.7557319e-07f; cp = cp * r2 + 2.4801587e-05f; cp = cp * r2 - 1.3888889e-03f; cp = cp * r2 + 4.1666667e-02f; cp = cp * r2 - 0.5f;
    const float cs = 1.0f + r2 * cp;
    const int qq = q & 3;
    c = (qq == 0) ? cs : (qq == 1) ? -sn : (qq == 2) ? -cs : sn;
    s = (qq == 0) ? sn : (qq == 1) ? cs : (qq == 2) ? -sn : -cs;
}
__device__ __forceinline__ float wave_sum2(float v) { v = sum16(v); v += __shfl_xor(v, 16); v += __shfl_xor(v, 32); return v; }
__device__ __forceinline__ void ln_rows4(const float* y0, const float* g, const float* b, float* h0, bf16_t* hb0, float* st0, bool final, int lane) {
    const f32x4* yr = (const f32x4*)y0 + lane; f32x4 v[4][8]; float s[4], q[4], mu[4], rs[4];
#pragma unroll
    for (int i = 0; i < 4; ++i)
#pragma unroll
        for (int j = 0; j < 8; ++j) v[i][j] = yr[512 * i + 64 * j];
#pragma unroll
    for (int i = 0; i < 4; ++i) { s[i] = 0.f;
#pragma unroll
        for (int j = 0; j < 8; ++j) s[i] += (v[i][j][0] + v[i][j][1]) + (v[i][j][2] + v[i][j][3]); }
#pragma unroll
    for (int i = 0; i < 4; ++i) mu[i] = wave_sum2(s[i]) * (1.f / 2048.f);
#pragma unroll
    for (int i = 0; i < 4; ++i) { q[i] = 0.f;
#pragma unroll
        for (int j = 0; j < 8; ++j) { v[i][j] = v[i][j] - mu[i]; q[i] += (v[i][j][0] * v[i][j][0] + v[i][j][1] * v[i][j][1]) + (v[i][j][2] * v[i][j][2] + v[i][j][3] * v[i][j][3]); } }
#pragma unroll
    for (int i = 0; i < 4; ++i) rs[i] = 1.0f / sqrtf(wave_sum2(q[i]) * (1.f / 2048.f) + 1e-5f);
    if (!final && lane == 0) { *(f32x4*)st0 = (f32x4){mu[0], rs[0], mu[1], rs[1]}; *(f32x4*)(st0 + 4) = (f32x4){mu[2], rs[2], mu[3], rs[3]}; }
#pragma unroll
    for (int j = 0; j < 8; ++j) { const f32x4 gg = ((const f32x4*)g)[lane + 64 * j], bb = ((const f32x4*)b)[lane + 64 * j];
#pragma unroll
        for (int i = 0; i < 4; ++i) { const f32x4 o = v[i][j] * rs[i] * gg + bb;
            if (final) ((f32x4*)h0)[512 * i + lane + 64 * j] = o;
            else { u32x2 w; w.x = cvt_pk_bf16(o[0], o[1]); w.y = cvt_pk_bf16(o[2], o[3]); ((u32x2*)hb0)[512 * i + lane + 64 * j] = w; } } }
}

__device__ __forceinline__ void ln_mix_rows4(const float* y0, int row0, const float* g, const float* b, const float* mix, bf16_t* X6, float* st0, int lane) {
    asm volatile("" : "+v"(lane));
    const f32x4* yr = (const f32x4*)y0 + lane;
    const bool has_prev = (row0 & 8191) != 0; float mp = 0.f, rp = 0.f;
    if (has_prev) { float s = 0.f, q = 0.f; f32x4 t[8];
#pragma unroll
        for (int j = 0; j < 8; ++j) { t[j] = yr[64 * j - 512]; s += (t[j][0] + t[j][1]) + (t[j][2] + t[j][3]); }
        mp = wave_sum2(s) * (1.f / 2048.f);
#pragma unroll
        for (int j = 0; j < 8; ++j) { t[j] = t[j] - mp; q += (t[j][0] * t[j][0] + t[j][1] * t[j][1]) + (t[j][2] * t[j][2] + t[j][3] * t[j][3]); }
        rp = 1.0f / sqrtf(wave_sum2(q) * (1.f / 2048.f) + 1e-5f); }
    asm volatile("" ::: "memory");
    f32x4 v[4][8]; float s[4], q[4], mu[4], rs[4];
#pragma unroll
    for (int i = 0; i < 4; ++i)
#pragma unroll
        for (int j = 0; j < 8; ++j) v[i][j] = yr[512 * i + 64 * j];
#pragma unroll
    for (int i = 0; i < 4; ++i) { s[i] = 0.f;
#pragma unroll
        for (int j = 0; j < 8; ++j) s[i] += (v[i][j][0] + v[i][j][1]) + (v[i][j][2] + v[i][j][3]); }
#pragma unroll
    for (int i = 0; i < 4; ++i) mu[i] = wave_sum2(s[i]) * (1.f / 2048.f);
#pragma unroll
    for (int i = 0; i < 4; ++i) { q[i] = 0.f;
#pragma unroll
        for (int j = 0; j < 8; ++j) { v[i][j] = v[i][j] - mu[i]; q[i] += (v[i][j][0] * v[i][j][0] + v[i][j][1] * v[i][j][1]) + (v[i][j][2] * v[i][j][2] + v[i][j][3] * v[i][j][3]); } }
#pragma unroll
    for (int i = 0; i < 4; ++i) rs[i] = 1.0f / sqrtf(wave_sum2(q[i]) * (1.f / 2048.f) + 1e-5f);
    if (lane == 0) { *(f32x4*)st0 = (f32x4){mu[0], rs[0], mu[1], rs[1]}; *(f32x4*)(st0 + 4) = (f32x4){mu[2], rs[2], mu[3], rs[3]}; }
#pragma unroll
    for (int j = 0; j < 8; ++j) { int pc = lane + 64 * j; asm volatile("" : "+v"(pc)); const f32x4 gg = ((const f32x4*)g)[pc], bb = ((const f32x4*)b)[pc];
        f32x4 hp = {0.f, 0.f, 0.f, 0.f}; if (has_prev) hp = (yr[64 * j - 512] - mp) * rp * gg + bb;
        f32x4 h[4];
#pragma unroll
        for (int i = 0; i < 4; ++i) h[i] = v[i][j] * rs[i] * gg + bb;
#pragma unroll
        for (int sl = 0; sl < 6; ++sl) { const int mr = (sl == 0) ? 0 : (sl == 1) ? 2 : (sl == 2) ? 3 : (sl == 3) ? 1 : sl; const f32x4 m4 = ((const f32x4*)(mix + mr * 2048))[pc];
#pragma unroll
            for (int i = 0; i < 4; ++i) { const f32x4 pv = (i == 0) ? hp : h[i - 1]; const f32x4 o = h[i] + (pv - h[i]) * m4;
                u32x2 w; w.x = cvt_pk_bf16(o[0], o[1]); w.y = cvt_pk_bf16(o[2], o[3]);
                ((u32x2*)(X6 + (size_t)sl * (SLOT / 2) + (size_t)(row0 + i) * 2048))[pc] = w; } }
        asm volatile("" ::: "memory"); }
}

constexpr int MK_STRIDE = 400, MV_STRIDE = 144, MK_BYTES = 64 * MK_STRIDE, MV_BYTES = 128 * MV_STRIDE, MBUF = MK_BYTES + MV_BYTES;
__device__ __forceinline__ void mla_attn_phase(LAS unsigned char* lds, const bf16_t* Q, const bf16_t* KN, const bf16_t* KR, const bf16_t* VT, bf16_t* O, int G, int bx, const int tid) {
    const int lane = tid & 63, wid = __builtin_amdgcn_readfirstlane(tid >> 6), r32 = lane & 31, hi = lane >> 5;
    const int vcu = (G % 8 == 0) ? (bx % 8) * (G / 8) + bx / 8 : bx;
    for (int ui = 0;; ++ui) {
        int bh, qb;
        if (G == 256) { if (ui >= 4) break; const int s = vcu & 7; bh = vcu >> 3; qb = (ui == 0) ? s : (ui == 1) ? 15 - s : (ui == 2) ? 16 + s : 31 - s; }
        else { const int L = ui * G + bx; if (L >= 1024) break; bh = L & 31; qb = 31 - (L >> 5); }
        const int b = bh >> 4, h = bh & 15; const size_t rowbase = (size_t)b * SEQ; const int q0 = qb * 256 + wid * 32;
        bf16x8 qf[12];
        { const bf16_t* qp = Q + (rowbase + q0 + r32) * 3072 + h * 192 + hi * 8;
#pragma unroll
            for (int d0 = 0; d0 < 12; ++d0) qf[d0] = *(const bf16x8*)(qp + d0 * 16); }
        const int NT = 4 * (qb + 1);
        f32x16 o[4];
#pragma unroll
        for (int i = 0; i < 4; ++i)
#pragma unroll
            for (int r = 0; r < 16; ++r) o[i][r] = 0.f;
        float mrun = -1e30f, lrun = 0.f;
        u32x4 kreg[3], vreg[2];
        const int kkey = tid >> 4, kpc = tid & 15, rkey = tid >> 3, rpc = tid & 7;
        const bf16_t* kn0 = KN + (rowbase + kkey) * 2048 + h * 128 + kpc * 8;
        const bf16_t* kr0 = KR + (rowbase + rkey) * 64 + rpc * 8;
        const bf16_t* vt0 = VT + ((size_t)(bh * 128 + (tid >> 3))) * 8192 + (tid & 7) * 8;
#define MLA_LOAD(j) do { kreg[0] = *(const u32x4*)(kn0 + (size_t)(64 * (j)) * 2048); kreg[1] = *(const u32x4*)(kn0 + (size_t)(64 * (j) + 32) * 2048); kreg[2] = *(const u32x4*)(kr0 + (size_t)(64 * (j)) * 64); \
        vreg[0] = *(const u32x4*)(vt0 + 64 * (j)); vreg[1] = *(const u32x4*)(vt0 + (size_t)64 * 8192 + 64 * (j)); } while (0)
#define MLA_STORE(buf) do { LAS unsigned char* kb_ = lds + (buf) * MBUF; LAS unsigned char* vb_ = kb_ + MK_BYTES; \
        *(LAS u32x4*)(kb_ + kkey * MK_STRIDE + kpc * 16) = kreg[0]; *(LAS u32x4*)(kb_ + (kkey + 32) * MK_STRIDE + kpc * 16) = kreg[1]; *(LAS u32x4*)(kb_ + rkey * MK_STRIDE + 256 + rpc * 16) = kreg[2]; \
        { LAS unsigned char* p_ = vb_ + (tid >> 3) * MV_STRIDE + ((tid & 7) >> 1) * 32 + (tid & 1) * 8; *(LAS u32x2*)p_ = (u32x2){vreg[0].x, vreg[0].y}; *(LAS u32x2*)(p_ + 16) = (u32x2){vreg[0].z, vreg[0].w}; \
          p_ += 64 * MV_STRIDE; *(LAS u32x2*)p_ = (u32x2){vreg[1].x, vreg[1].y}; *(LAS u32x2*)(p_ + 16) = (u32x2){vreg[1].z, vreg[1].w}; } } while (0)
        MLA_LOAD(0); MLA_STORE(0);
        __syncthreads();
        for (int j = 0; j < NT; ++j) {
            const int buf = j & 1;
            if (j + 1 < NT) MLA_LOAD(j + 1);
            if (64 * j <= q0 + 31) {
                const LAS unsigned char* kb = lds + buf * MBUF; const LAS unsigned char* vb = kb + MK_BYTES;
                f32x16 st[2];
#pragma unroll
                for (int kvh = 0; kvh < 2; ++kvh)
#pragma unroll
                    for (int r = 0; r < 16; ++r) st[kvh][r] = 0.f;
                { const LAS unsigned char* kp0 = kb + r32 * MK_STRIDE + hi * 16; const LAS unsigned char* kp1 = kp0 + 32 * MK_STRIDE;
#define MLA_KF(i) (*(const LAS bf16x8*)((((i) & 1) ? kp1 : kp0) + ((i) >> 1) * 32))
                    bf16x8 kq[6];
#pragma unroll
                    for (int i = 0; i < 6; ++i) kq[i] = MLA_KF(i);
                    __builtin_amdgcn_sched_barrier(0);
#pragma unroll
                    for (int i = 0; i < 24; ++i) { st[i & 1] = __builtin_amdgcn_mfma_f32_32x32x16_bf16(kq[i % 6], qf[i >> 1], st[i & 1], 0, 0, 0);
                        if (i + 6 < 24) kq[i % 6] = MLA_KF(i + 6);
                        __builtin_amdgcn_sched_barrier(0); }
#undef MLA_KF
                }
                if (64 * j + 63 > q0) {
                    const int qg = q0 + r32;
#pragma unroll
                    for (int kvh = 0; kvh < 2; ++kvh)
#pragma unroll
                        for (int r = 0; r < 16; ++r) { const int kg = 64 * j + 32 * kvh + crow(r, hi); if (kg > qg) st[kvh][r] = -1e30f; }
                }
                const LAS unsigned char* vp0 = vb + r32 * MV_STRIDE + hi * 16;
#define MLA_VF(i) (*(const LAS bf16x8*)(vp0 + ((i) & 3) * (32 * MV_STRIDE) + ((i) >> 2) * 32))
                bf16x8 vq[4];
#pragma unroll
                for (int i = 0; i < 4; ++i) vq[i] = MLA_VF(i);
                float mx = st[0][0];
#pragma unroll
                for (int r = 1; r < 16; ++r) mx = fmaxf(mx, st[0][r]);
#pragma unroll
                for (int r = 0; r < 16; ++r) mx = fmaxf(mx, st[1][r]);
                mx = fmaxf(mx, __shfl_xor(mx, 32));
                const float mnew = (mx > mrun + 8.0f) ? mx : mrun;
                if (__any(mnew != mrun)) { const float alpha = __builtin_amdgcn_exp2f(mrun - mnew); lrun *= alpha;
#pragma unroll
                    for (int i = 0; i < 4; ++i)
#pragma unroll
                        for (int r = 0; r < 16; ++r) o[i][r] *= alpha;
                    mrun = mnew; }
                float ps = 0.f;
#pragma unroll
                for (int kvh = 0; kvh < 2; ++kvh)
#pragma unroll
                    for (int r = 0; r < 16; ++r) { const float p = __builtin_amdgcn_exp2f(st[kvh][r] - mrun); st[kvh][r] = p; ps += p; }
                lrun += ps;
                bf16x8 pf[4];
#pragma unroll
                for (int ks = 0; ks < 4; ++ks) { const int kvh = ks >> 1, rb = 8 * (ks & 1); u32x4 w;
                    w.x = cvt_pk_bf16(st[kvh][rb + 0], st[kvh][rb + 1]); w.y = cvt_pk_bf16(st[kvh][rb + 2], st[kvh][rb + 3]); w.z = cvt_pk_bf16(st[kvh][rb + 4], st[kvh][rb + 5]); w.w = cvt_pk_bf16(st[kvh][rb + 6], st[kvh][rb + 7]);
                    pf[ks] = __builtin_bit_cast(bf16x8, w); }
                __builtin_amdgcn_sched_barrier(0);
#pragma unroll
                for (int i = 0; i < 16; ++i) { o[i & 3] = __builtin_amdgcn_mfma_f32_32x32x16_bf16(vq[i % 4], pf[i >> 2], o[i & 3], 0, 0, 0);
                    if (i + 4 < 16) vq[i % 4] = MLA_VF(i + 4);
                    __builtin_amdgcn_sched_barrier(0); }
#undef MLA_VF
            }
            if (j + 1 < NT) MLA_STORE(buf ^ 1);
            __syncthreads();
        }
        lrun += __shfl_xor(lrun, 32);
        const float inv = 1.0f / lrun;
        bf16_t* op = O + (rowbase + q0 + r32) * 2048 + h * 128 + 4 * hi;
#pragma unroll
        for (int dvb = 0; dvb < 4; ++dvb)
#pragma unroll
            for (int g4 = 0; g4 < 4; ++g4) { u32x2 w; w.x = cvt_pk_bf16(o[dvb][4 * g4] * inv, o[dvb][4 * g4 + 1] * inv); w.y = cvt_pk_bf16(o[dvb][4 * g4 + 2] * inv, o[dvb][4 * g4 + 3] * inv);
                *(u32x2*)(op + 32 * dvb + 8 * g4) = w; }
#undef MLA_LOAD
#undef MLA_STORE
    }
}

constexpr int SK_STRIDE = 144, SV_STRIDE = 520, SK_BYTES = 256 * SK_STRIDE, SV_BYTES = 64 * SV_STRIDE, SB_OFF = SK_BYTES + SV_BYTES;
__device__ __forceinline__ void swa_attn_phase(LAS unsigned char* lds, const bf16_t* Q, const bf16_t* Kg, const bf16_t* VT, bf16_t* O, const float* bt2, const float* sinks, int G, int bx, const int tid) {
    const int lane = tid & 63, wid = __builtin_amdgcn_readfirstlane(tid >> 6), r32 = lane & 31, hi = lane >> 5;
    LAS unsigned char* ks_ = lds; LAS unsigned char* vs_ = lds + SK_BYTES; LAS float* bs_ = (LAS float*)(lds + SB_OFF);
    for (int L = bx; L < 512; L += G) {
        const int hk = L & 3, blk = (L >> 2) & 63, b = L >> 8;
        const size_t rowbase = (size_t)b * SEQ; const int t0 = blk * 128 - 128;
#pragma unroll
        for (int i = 0; i < 4; ++i) { const int p = tid + 512 * i, key = p >> 3, pc = p & 7; u32x4 v = {0u, 0u, 0u, 0u};
            if (t0 + key >= 0) v = *(const u32x4*)(Kg + (rowbase + t0 + key) * 256 + hk * 64 + pc * 8);
            *(LAS u32x4*)(ks_ + key * SK_STRIDE + pc * 16) = v; }
#pragma unroll
        for (int i = 0; i < 4; ++i) { const int p = tid + 512 * i, dv = p >> 5, pc = p & 31; u32x4 v = {0u, 0u, 0u, 0u};
            if (t0 + pc * 8 >= 0) v = *(const u32x4*)(VT + ((size_t)((b * 4 + hk) * 64 + dv)) * 8192 + t0 + pc * 8);
            LAS unsigned char* p_ = vs_ + dv * SV_STRIDE + pc * 16; *(LAS u32x2*)p_ = (u32x2){v.x, v.y}; *(LAS u32x2*)(p_ + 8) = (u32x2){v.z, v.w}; }
        for (int i = tid; i < 1024; i += 512) bs_[i] = bt2[(hk * 8) * 128 + i];
        __syncthreads();
        for (int ci = 0; ci < 4; ++ci) {
            const int c = wid + 8 * ci, g = c >> 2, qs = c & 3, head = hk * 8 + g;
            const size_t qrow = rowbase + blk * 128 + 32 * qs + r32;
            bf16x8 qf[4];
#pragma unroll
            for (int d0 = 0; d0 < 4; ++d0) qf[d0] = *(const bf16x8*)(Q + qrow * 2048 + head * 64 + d0 * 16 + hi * 8);
            const float sink2 = sinks[head] * LOG2E;
            float mrun = sink2, lrun = (hi == 0) ? 1.0f : 0.0f;
            f32x16 o[2];
#pragma unroll
            for (int i = 0; i < 2; ++i)
#pragma unroll
                for (int r = 0; r < 16; ++r) o[i][r] = 0.f;
#pragma unroll 1
            for (int kb = 0; kb < 5; ++kb) {
                f32x16 st;
#pragma unroll
                for (int r = 0; r < 16; ++r) st[r] = 0.f;
                const LAS unsigned char* kp_ = ks_ + (32 * (qs + kb) + r32) * SK_STRIDE + hi * 16;
#pragma unroll
                for (int d0 = 0; d0 < 4; ++d0) { const bf16x8 kf = *(const LAS bf16x8*)(kp_ + d0 * 32); st = __builtin_amdgcn_mfma_f32_32x32x16_bf16(kf, qf[d0], st, 0, 0, 0); }
                float mx = -1e30f;
#pragma unroll
                for (int r = 0; r < 16; ++r) { const int kl = 32 * kb + crow(r, hi);
                    const int dist = r32 + 128 - kl; const bool ok = (dist >= 0) && (dist < 128) && (t0 + 32 * qs + kl >= 0);
                    const float bv = bs_[g * 128 + (dist & 127)];
                    const float sv = ok ? st[r] + bv : -1e30f; st[r] = sv; mx = fmaxf(mx, sv); }
                mx = fmaxf(mx, __shfl_xor(mx, 32));
                const float mnew = fmaxf(mrun, mx), alpha = __builtin_amdgcn_exp2f(mrun - mnew); mrun = mnew;
                float ps = 0.f;
#pragma unroll
                for (int r = 0; r < 16; ++r) { const float p = __builtin_amdgcn_exp2f(st[r] - mnew); st[r] = p; ps += p; }
                lrun = lrun * alpha + ps;
#pragma unroll
                for (int i = 0; i < 2; ++i)
#pragma unroll
                    for (int r = 0; r < 16; ++r) o[i][r] *= alpha;
#pragma unroll
                for (int k2 = 0; k2 < 2; ++k2) { const int rb = 8 * k2; u32x4 w;
                    w.x = cvt_pk_bf16(st[rb + 0], st[rb + 1]); w.y = cvt_pk_bf16(st[rb + 2], st[rb + 3]); w.z = cvt_pk_bf16(st[rb + 4], st[rb + 5]); w.w = cvt_pk_bf16(st[rb + 6], st[rb + 7]);
                    const bf16x8 pf = __builtin_bit_cast(bf16x8, w);
#pragma unroll
                    for (int dvb = 0; dvb < 2; ++dvb) { const LAS unsigned char* vp = vs_ + (32 * dvb + r32) * SV_STRIDE + (32 * (qs + kb) + 16 * k2 + 4 * hi) * 2;
                        const u32x2 lo = *(const LAS u32x2*)vp, hi2 = *(const LAS u32x2*)(vp + 16); const u32x4 vw = {lo.x, lo.y, hi2.x, hi2.y};
                        o[dvb] = __builtin_amdgcn_mfma_f32_32x32x16_bf16(__builtin_bit_cast(bf16x8, vw), pf, o[dvb], 0, 0, 0); } }
            }
            lrun += __shfl_xor(lrun, 32);
            const float inv = 1.0f / lrun;
            bf16_t* op = O + qrow * 2048 + head * 64 + 4 * hi;
#pragma unroll
            for (int dvb = 0; dvb < 2; ++dvb)
#pragma unroll
                for (int g4 = 0; g4 < 4; ++g4) { u32x2 w; w.x = cvt_pk_bf16(o[dvb][4 * g4] * inv, o[dvb][4 * g4 + 1] * inv); w.y = cvt_pk_bf16(o[dvb][4 * g4 + 2] * inv, o[dvb][4 * g4 + 3] * inv);
                    *(u32x2*)(op + 32 * dvb + 8 * g4) = w; }
        }
        __syncthreads();
    }
}

__device__ __forceinline__ void rwkv_mix_phase(const float* y, const float* stats, const float* lg, const float* lb, const float* mix, bf16_t* X6, int gt, int NGT) {
    for (int idx = gt; idx < M * 256; idx += NGT) { const int row = idx >> 8, c = (idx & 255) * 8; const size_t off = (size_t)row * 2048 + c;
        const f32x4 g0 = *(const f32x4*)(lg + c), g1 = *(const f32x4*)(lg + c + 4), b0 = *(const f32x4*)(lb + c), b1 = *(const f32x4*)(lb + c + 4);
        const f32x2 ms = *(const f32x2*)(stats + 2 * (size_t)row);
        const f32x4 x0 = (*(const f32x4*)(y + off) - ms[0]) * ms[1] * g0 + b0, x1 = (*(const f32x4*)(y + off + 4) - ms[0]) * ms[1] * g1 + b1; f32x4 p0 = {0.f, 0.f, 0.f, 0.f}, p1 = p0;
        if ((row & 8191) != 0) { const f32x2 mp = *(const f32x2*)(stats + 2 * (size_t)row - 2); p0 = (*(const f32x4*)(y + off - 2048) - mp[0]) * mp[1] * g0 + b0; p1 = (*(const f32x4*)(y + off - 2044) - mp[0]) * mp[1] * g1 + b1; }
        const f32x4 d0 = p0 - x0, d1 = p1 - x1;
#pragma unroll
        for (int s = 0; s < 6; ++s) { const int mr = (s == 0) ? 0 : (s == 1) ? 2 : (s == 2) ? 3 : (s == 3) ? 1 : s;
            const f32x4 m0 = *(const f32x4*)(mix + mr * 2048 + c), m1 = *(const f32x4*)(mix + mr * 2048 + c + 4);
            *(u32x4*)(X6 + (size_t)s * (SLOT / 2) + off) = pack8(x0 + d0 * m0, x1 + d1 * m1); }
    }
}
constexpr int SC_T = 32, SC_TOK = 1536, SC_BUF = SC_T * SC_TOK;
__device__ __forceinline__ void rwkv_scan_phase(LAS unsigned char* lds, const bf16_t* RKV, const float* DEC, const float* AF, const float* k_k, const float* k_a, const float* r_k, float* BON, float* Y, int bx, const int tid) {
    const int lane = tid & 63, wid = __builtin_amdgcn_readfirstlane(tid >> 6);
    const int bh = bx >> 2, rq = bx & 3, b = bh >> 5, h = bh & 31; const size_t rowbase = (size_t)b * SEQ;
    const int ptid = tid - 256, ptok = ptid >> 4, pc4 = (ptid & 15) * 4;
    f32x4 kk4 = {0.f, 0.f, 0.f, 0.f}, ka4 = kk4, rk4 = kk4;
    if (wid >= 4) { kk4 = *(const f32x4*)(k_k + h * 64 + pc4); ka4 = *(const f32x4*)(k_a + h * 64 + pc4); rk4 = *(const f32x4*)(r_k + h * 64 + pc4); }
    u32x2 prw[2], pkw[2], pvw[2]; f32x4 pw4[2], pa4[2];
#pragma unroll
    for (int i = 0; i < 2; ++i) { prw[i] = (u32x2){0u, 0u}; pkw[i] = prw[i]; pvw[i] = prw[i]; pw4[i] = (f32x4){0.f, 0.f, 0.f, 0.f}; pa4[i] = pw4[i]; }
#define SCAN_LOAD(c) do { _Pragma("unroll") for (int ps_ = 0; ps_ < 2; ++ps_) { const int tl = ptok + 16 * ps_; const size_t off = (rowbase + (size_t)(c) * SC_T + tl) * 2048 + h * 64 + pc4; \
        prw[ps_] = *(const u32x2*)(RKV + off); pkw[ps_] = *(const u32x2*)(RKV + (SLOT / 2) + off); pvw[ps_] = *(const u32x2*)(RKV + 2 * (SLOT / 2) + off); \
        pw4[ps_] = *(const f32x4*)(DEC + off); pa4[ps_] = *(const f32x4*)(AF + off); } } while (0)
#define SCAN_STORE(buf, c) do { _Pragma("unroll") for (int ps_ = 0; ps_ < 2; ++ps_) { const int tl = ptok + 16 * ps_; const u32x2 rw = prw[ps_], kw = pkw[ps_], vw = pvw[ps_]; const f32x4 w4 = pw4[ps_], a4 = pa4[ps_]; \
        const f32x4 r4 = {bflo(rw.x), bfhi(rw.x), bflo(rw.y), bfhi(rw.y)}, k4 = {bflo(kw.x), bfhi(kw.x), bflo(kw.y), bfhi(kw.y)}, v4 = {bflo(vw.x), bfhi(vw.x), bflo(vw.y), bfhi(vw.y)}; \
        const f32x4 kr = k4 * kk4; float ss = (kr[0] * kr[0] + kr[1] * kr[1]) + (kr[2] * kr[2] + kr[3] * kr[3]); ss = sum16(ss); \
        const float rn = 1.0f / fmaxf(sqrtf(ss), 1e-12f); const f32x4 kn = kr * rn; const f32x4 kp = k4 * (1.0f + (a4 - 1.0f) * ka4); \
        { const f32x4 tb = r4 * kp * rk4; const float bon = sum16((tb[0] + tb[1]) + (tb[2] + tb[3])); if (rq == 0 && pc4 == 0) BON[(rowbase + (size_t)(c) * SC_T + tl) * 32 + h] = bon; } \
        LAS unsigned char* d_ = lds + (buf) * SC_BUF + tl * SC_TOK + pc4 * 4; \
        *(LAS f32x4*)(d_) = r4; *(LAS f32x4*)(d_ + 256) = w4; *(LAS f32x4*)(d_ + 512) = kp; *(LAS f32x4*)(d_ + 768) = v4; *(LAS f32x4*)(d_ + 1024) = -kn; *(LAS f32x4*)(d_ + 1280) = kn * a4; } } while (0)
    const int ks4 = (lane & 15) * 16, rowi = 16 * rq + 4 * wid + (lane >> 4);
    f32x2 S01 = {0.f, 0.f}, S23 = {0.f, 0.f};
    float* yp = Y + rowbase * 2048 + h * 64 + rowi;
    if (wid >= 4) { SCAN_LOAD(0); SCAN_STORE(0, 0); SCAN_LOAD(1); }
    __syncthreads();
    for (int c = 0; c < SEQ / SC_T; ++c) {
        if (wid >= 4) { if (c + 1 < SEQ / SC_T) { SCAN_STORE((c + 1) & 1, c + 1); if (c + 2 < SEQ / SC_T) SCAN_LOAD(c + 2); } }
        else {
            const LAS unsigned char* base = lds + (c & 1) * SC_BUF + ks4; const LAS unsigned char* vbase = lds + (c & 1) * SC_BUF + 768 + rowi * 4;
            f32x4 r4 = *(const LAS f32x4*)(base), w4 = *(const LAS f32x4*)(base + 256), k4 = *(const LAS f32x4*)(base + 512), a4 = *(const LAS f32x4*)(base + 1024), b4 = *(const LAS f32x4*)(base + 1280);
            float vv = *(const LAS float*)(vbase); float ykeep = 0.f;
#pragma unroll
            for (int t = 0; t < SC_T; ++t) {
                f32x4 r4n = r4, w4n = w4, k4n = k4, a4n = a4, b4n = b4; float vvn = vv;
                if (t + 1 < SC_T) { const LAS unsigned char* p = base + (t + 1) * SC_TOK;
                    r4n = *(const LAS f32x4*)(p); w4n = *(const LAS f32x4*)(p + 256); k4n = *(const LAS f32x4*)(p + 512); a4n = *(const LAS f32x4*)(p + 1024); b4n = *(const LAS f32x4*)(p + 1280);
                    vvn = *(const LAS float*)(vbase + (t + 1) * SC_TOK); }
                const f32x2 a01 = {a4[0], a4[1]}, a23 = {a4[2], a4[3]}, w01 = {w4[0], w4[1]}, w23 = {w4[2], w4[3]}, b01 = {b4[0], b4[1]}, b23 = {b4[2], b4[3]}, k01 = {k4[0], k4[1]}, k23 = {k4[2], k4[3]}, r01 = {r4[0], r4[1]}, r23 = {r4[2], r4[3]};
                const f32x2 tsa = S01 * a01 + S23 * a23; const float sa = sum16(tsa[0] + tsa[1]);
                S01 = S01 * w01 + (b01 * sa + k01 * vv); S23 = S23 * w23 + (b23 * sa + k23 * vv);
                const f32x2 ty = S01 * r01 + S23 * r23; const float y = sum16(ty[0] + ty[1]);
                ykeep = ((lane & 15) == (t & 15)) ? y : ykeep;
                if ((t & 15) == 15) yp[(size_t)(c * SC_T + (t - 15) + (lane & 15)) * 2048] = ykeep;
                r4 = r4n; w4 = w4n; k4 = k4n; a4 = a4n; b4 = b4n; vv = vvn;
            }
        }
        __syncthreads();
    }
#undef SCAN_LOAD
#undef SCAN_STORE
}
__device__ __forceinline__ void rwkv_gn_phase(const float* Y, const bf16_t* Vb, const float* BON, const bf16_t* GB, const float* ln_g, const float* ln_b, bf16_t* YG, int gw, int NGW, int lane) {
    const int c4 = (lane & 15) * 4, sub = lane >> 4;
    for (int it = gw * 4 + sub; it < M * 32; it += NGW * 4) { const int row = it >> 5, h = it & 31; const int ch = h * 64 + c4; const size_t off = (size_t)row * 2048 + ch;
        const f32x4 y4 = *(const f32x4*)(Y + off);
        const u32x2 vw = *(const u32x2*)(Vb + off), gw2 = *(const u32x2*)(GB + off); const float bonus = BON[it];
        const f32x4 lg = *(const f32x4*)(ln_g + ch), lb = *(const f32x4*)(ln_b + ch);
        const float mean = sum16((y4[0] + y4[1]) + (y4[2] + y4[3])) * (1.f / 64.f); const f32x4 d = y4 - mean;
        const float var = sum16((d[0] * d[0] + d[1] * d[1]) + (d[2] * d[2] + d[3] * d[3])) * (1.f / 64.f); const float rstd = 1.0f / sqrtf(var + 64e-5f);
        const f32x4 v4 = {bflo(vw.x), bfhi(vw.x), bflo(vw.y), bfhi(vw.y)}, g4 = {bflo(gw2.x), bfhi(gw2.x), bflo(gw2.y), bfhi(gw2.y)};
        const f32x4 outv = (d * rstd * lg + lb + v4 * bonus) * g4;
        u32x2 w; w.x = cvt_pk_bf16(outv[0], outv[1]); w.y = cvt_pk_bf16(outv[2], outv[3]); *(u32x2*)(YG + off) = w; }
}

#define XB_TMO      128
#define XB_XCNT(j)  (256  + 64 * (j))
#define XB_XSUB(j)  (1280 + 64 * (j))
#define XB_XGEN(j)  (2304 + 64 * (j))
#define XB_TOP      3328
#define XB_TOPGEN   3392
#define XCD_BAR_WORDS 3456
#define XB_SPIN_CAP (1u << 18)
__device__ __forceinline__ unsigned xb_ld(unsigned* p)              { return __hip_atomic_load(p, __ATOMIC_RELAXED, __HIP_MEMORY_SCOPE_AGENT); }
__device__ __forceinline__ unsigned xb_add(unsigned* p, unsigned v) { return __hip_atomic_fetch_add(p, v, __ATOMIC_RELAXED, __HIP_MEMORY_SCOPE_AGENT); }
__device__ __forceinline__ unsigned xb_xcc_id() { return (unsigned)__builtin_amdgcn_s_getreg((3 << 11) | 20) & 0xFu; }
#define XB_SPIN(cond, bar) do { unsigned _sp = 0; while (cond) { __builtin_amdgcn_s_sleep(1); \
    if ((++_sp & 255u) == 0u) { if (xb_ld(&(bar)[XB_TMO])) break; if (_sp > XB_SPIN_CAP) { atomicAdd(&(bar)[XB_TMO], 1u); break; } } } } while (0)
struct XcdBarrier { unsigned* bar; unsigned x; volatile LAS unsigned* st; };
__device__ __forceinline__ XcdBarrier xcd_barrier_post(unsigned* bar, volatile LAS unsigned* st) {
    XcdBarrier b; b.bar = bar; b.x = xb_xcc_id(); b.st = st;
    if (threadIdx.x == 0) (void)xb_add(&bar[XB_XCNT(b.x)], 1u);
    return b;
}
__device__ __forceinline__ void xcd_barrier_complete(unsigned* bar, unsigned x, unsigned& nloc, unsigned& nx) {
    const unsigned G = gridDim.x * gridDim.y * gridDim.z;
    unsigned sum, cnt, mine, sp = 0u;
    for (;;) {
        sum = 0u; cnt = 0u; mine = 0u;
#pragma unroll
        for (unsigned j = 0; j < 16; ++j) { const unsigned c = xb_ld(&bar[XB_XCNT(j)]); sum += c; cnt += (c > 0u) ? 1u : 0u; mine = (j == x) ? c : mine; }
        if (sum == G) break;
        __builtin_amdgcn_s_sleep(1);
        if ((++sp & 255u) == 0u) { if (xb_ld(&bar[XB_TMO])) break; if (sp > XB_SPIN_CAP) { atomicAdd(&bar[XB_TMO], 1u); break; } }
    }
    nloc = mine > 0u ? mine : 1u; nx = cnt > 0u ? cnt : 1u;
}
__device__ __forceinline__ void xcd_barrier(const XcdBarrier& b) {
    asm volatile("s_waitcnt vmcnt(0)" ::: "memory");
    __syncthreads();
    if (threadIdx.x == 0) {
        unsigned* bar = b.bar;
        __builtin_amdgcn_s_waitcnt(0);
        unsigned nloc = b.st[0], nx = b.st[1];
        if (nloc == 0u) { xcd_barrier_complete(bar, b.x, nloc, nx); b.st[0] = nloc; b.st[1] = nx; }
        const unsigned old = xb_add(&bar[XB_XSUB(b.x)], 1u);
        const unsigned gen = old / nloc;
        if (old + 1u == (gen + 1u) * nloc) {
            __builtin_amdgcn_fence(__ATOMIC_RELEASE, "agent");
            asm volatile("s_waitcnt vmcnt(0)" ::: "memory");
            const unsigned og = xb_add(&bar[XB_TOP], 1u);
            const unsigned tg = og / nx;
            if (og + 1u == (tg + 1u) * nx) xb_add(&bar[XB_TOPGEN], 1u);
            else XB_SPIN(xb_ld(&bar[XB_TOPGEN]) == tg, bar);
            __builtin_amdgcn_fence(__ATOMIC_ACQUIRE, "agent");
            xb_add(&bar[XB_XGEN(b.x)], 1u);
            asm volatile("s_waitcnt vmcnt(0)" ::: "memory");
        } else {
            XB_SPIN(xb_ld(&bar[XB_XGEN(b.x)]) == gen, bar);
            __builtin_amdgcn_fence(__ATOMIC_ACQUIRE, "agent");
            asm volatile("s_waitcnt vmcnt(0)" ::: "memory");
        }
    }
    __syncthreads();
}

struct Args { const float* in[33]; float* out; unsigned char* ws; int ph_lo, ph_hi; };
#ifndef PROBE_N
#define PROBE_N 0
#define PROBE_MAP(i) 0
#endif
constexpr int N_PHASES = 36 + PROBE_N;
typedef const __attribute__((address_space(4))) unsigned char* kargp_t;
#define IN(i) (*(const float* const __attribute__((address_space(4)))*)(kp + 8 * (i)))
__global__ void __launch_bounds__(512, 2) hybrid_fwd(Args args) {
    extern __shared__ __attribute__((aligned(16))) unsigned char lds_raw[];
    LAS unsigned char* lds = (LAS unsigned char*)lds_raw;
    cg::grid_group grid = cg::this_grid();
    const kargp_t karg = (kargp_t)__builtin_amdgcn_kernarg_segment_ptr();
    const int ph_lo = args.ph_lo, ph_hi = args.ph_hi;
    volatile LAS unsigned* MISC = (volatile LAS unsigned*)(lds + LDS_BYTES - 256);
    if (threadIdx.x < 64) MISC[threadIdx.x] = 0u;
    __syncthreads();
    const XcdBarrier xb = xcd_barrier_post((unsigned*)(args.ws + WS_BAR), MISC + 8);

    for (int phx = ph_lo; phx < ph_hi; ++phx) {
        const int ph = (phx < 36) ? phx : (PROBE_MAP(phx - 36));
        int tid = threadIdx.x; asm volatile("" : "+v"(tid));
        const int lane = tid & 63, wave = __builtin_amdgcn_readfirstlane(tid >> 6);
        int G = gridDim.x, bx = blockIdx.x; asm volatile("" : "+s"(G), "+s"(bx));
        const int gw = bx * 8 + wave, NGW = G * 8, gt = bx * 512 + tid, NGT = G * 512;
        LAS float* scr = (LAS float*)(lds + wave * 16640);
        kargp_t kp = karg; asm volatile("" : "+s"(kp));
        float* hout = *(float* const __attribute__((address_space(4)))*)(kp + 8 * 33); unsigned char* ws = *(unsigned char* const __attribute__((address_space(4)))*)(kp + 8 * 34);
        unsigned char* ar = ws + WS_AR; const float* x_in = IN(0);
        bf16_t* HB = (bf16_t*)(ws + WS_HB); float* Yb = (float*)(ws + WS_Y);
        float* tab = (float*)(ws + WS_TAB); float* bt2 = (float*)(ws + WS_BT); float* stats = (float*)(ws + WS_STATS);
        int layer, kind, sub;
        if (ph == 0 || ph >= 100) { layer = -1; kind = -1; sub = 0; }
        else if (ph < 10) { layer = 0; kind = 0; sub = ph - 1; }
        else if (ph < 20) { layer = 1; kind = 1; sub = ph - 10; }
        else if (ph < 27) { layer = 2; kind = 2; sub = ph - 20; }
        else { layer = 3; kind = 0; sub = ph - 27; }
        const int nsub = (kind == 0) ? 9 : (kind == 1) ? 10 : 7;
        const int tail = sub - (nsub - 4);
        const bool nosync = (kind == 0 && sub == 2) || (kind == 1 && sub == 1);
        if (phx > ph_lo && !nosync) { if (phx == 1) grid.sync(); else xcd_barrier(xb); }
        const float* hres = (layer <= 0) ? x_in : Yb;
        const float* rg = (layer <= 0) ? nullptr : IN(29) + (size_t)((layer - 1) * 2 + 1) * 2048; const float* rb = (layer <= 0) ? nullptr : IN(30) + (size_t)((layer - 1) * 2 + 1) * 2048;
        pg8::Gemm g0{}; EpiP e0{}; int ng = 0;

        if (ph >= 100) {
        } else if (ph == 0) {
            for (int job = 0; job < 18; ++job) {
                const float* W = nullptr; int Ks = 0, Ns = 0, ldwt = 0, Nd = 0, kd = 0; const float* rs = nullptr; bf16_t* WT = nullptr;
                if (job < 8) { const int j = job >> 2, w = job & 3; unsigned char* base = ws + WS_MLA_W + (size_t)j * 20 * MiB;
                    if (w == 0) { W = IN(1) + (size_t)j * 2048 * 1088; Ks = 2048; Ns = 1088; WT = (bf16_t*)base; ldwt = 2048; Nd = 1280; kd = 1; }
                    else if (w == 1) { W = IN(4) + (size_t)j * 512 * 3072; Ks = 512; Ns = 3072; WT = (bf16_t*)(base + 5 * MiB); ldwt = 512; Nd = 3072; kd = 2; rs = IN(2) + j * 512; }
                    else if (w == 2) { W = IN(5) + (size_t)j * 512 * 4096; Ks = 512; Ns = 4096; WT = (bf16_t*)(base + 8 * MiB); ldwt = 512; Nd = 4096; kd = 0; rs = IN(3) + j * 512; }
                    else { W = IN(6) + (size_t)j * 2048 * 2048; Ks = 2048; Ns = 2048; WT = (bf16_t*)(base + 12 * MiB); ldwt = 2048; Nd = 2048; kd = 0; } }
                else if (job < 11) { const int n = job - 8; W = IN(8) + (size_t)n * 2048 * 2048; Ks = 2048; Ns = 2048; WT = (bf16_t*)(ws + WS_RW_W) + (size_t)n * 2048 * 2048; ldwt = 2048; Nd = 2048; }
                else if (job == 11) { W = IN(10); Ks = 2048; Ns = 96; WT = (bf16_t*)(ws + WS_RW_W + 24 * MiB); ldwt = 2048; Nd = 256; }
                else if (job == 12) { W = IN(13); Ks = 2048; Ns = 96; WT = (bf16_t*)(ws + WS_RW_W + 24 * MiB) + (size_t)256 * 2048; ldwt = 2048; Nd = 256; }
                else if (job == 13) { W = IN(15); Ks = 2048; Ns = 256; WT = (bf16_t*)(ws + WS_RW_W + 24 * MiB) + (size_t)512 * 2048; ldwt = 2048; Nd = 256; }
                else if (job == 14) { W = IN(16); Ks = 256; Ns = 2048; WT = (bf16_t*)(ws + WS_RW_W + 27 * MiB) + (size_t)4096 * 256; ldwt = 256; Nd = 2048; }
                else if (job == 15) { W = IN(22); Ks = 2048; Ns = 2048; WT = (bf16_t*)(ws + WS_RW_W + 30 * MiB); ldwt = 2048; Nd = 2048; }
                else if (job == 16) { W = IN(23); Ks = 2048; Ns = 2560; WT = (bf16_t*)(ws + WS_SW_W); ldwt = 2048; Nd = 2560; }
                else { W = IN(26); Ks = 2048; Ns = 2048; WT = (bf16_t*)(ws + WS_SW_W + 10 * MiB); ldwt = 2048; Nd = 2048; }
                transpose_w(W, Ks, Ns, WT, ldwt, Nd, kd, rs, scr, (gw + job * 227) % NGW, NGW, lane);
            }
            transpose_small(IN(11), (bf16_t*)(ws + WS_RW_W + 27 * MiB), gt, NGT);
            transpose_small(IN(14), (bf16_t*)(ws + WS_RW_W + 27 * MiB) + (size_t)2048 * 256, gt, NGT);
            for (int idx = gt; idx < 8192 * 32; idx += NGT) { const int pos = idx >> 5, i = idx & 31;
                float c, s; rope_cs(pos, i, c, s);
                tab[2 * idx] = c; tab[2 * idx + 1] = s; }
            { const float* rb = IN(28);
            for (int idx = gt; idx < 32 * 128; idx += NGT) { const int hd = idx >> 7, n = idx & 127; int bucket;
                if (n < 16) bucket = n; else { const float nf = (float)n; int lg = 16 + (int)(logf(nf / 16.0f) / 2.0794415416798357f * 16.0f); lg = lg < 31 ? lg : 31; bucket = lg; }
                bt2[idx] = rb[bucket * 32 + hd] * LOG2E; } }
            for (int idx = gt; idx < M * 256; idx += NGT) { const size_t off = (size_t)idx * 8; *(u32x4*)(HB + off) = pack8(*(const f32x4*)(x_in + off), *(const f32x4*)(x_in + off + 4)); }
        } else if (tail == 0 || tail == 3) {
            const float* lg = IN(29) + (size_t)(layer * 2 + (tail == 3 ? 1 : 0)) * 2048; const float* lb = IN(30) + (size_t)(layer * 2 + (tail == 3 ? 1 : 0)) * 2048;
            if (tail == 0) {
                transpose_w(IN(31) + (size_t)layer * 2048 * 8192, 2048, 8192, (bf16_t*)(ws + WS_MLPW), 2048, 8192, 0, nullptr, scr, gw, NGW, lane);
                transpose_w(IN(32) + (size_t)layer * 8192 * 2048, 8192, 2048, (bf16_t*)(ws + WS_MLPW + 32 * MiB), 8192, 2048, 0, nullptr, scr, gw, NGW, lane);
            }
            if (layer == 0 && tail == 3) {
                for (int row = gw * 4; row < M; row += NGW * 4) ln_mix_rows4(Yb + (size_t)row * 2048, row, lg, lb, IN(7), (bf16_t*)(ar + AR_X6), stats + 2 * (size_t)row, lane);
            } else {
                for (int row = gw * 4; row < M; row += NGW * 4) ln_rows4(Yb + (size_t)row * 2048, lg, lb, hout + (size_t)row * 2048, HB + (size_t)row * 2048, stats + 2 * (size_t)row, layer == 3 && tail == 3, lane);
            }
        } else if (tail == 1) {
            g0 = pg8::Gemm{HB, (const bf16_t*)(ws + WS_MLPW), M, FF, 2048, 2048, 2048, 1 << 20, 0}; e0.mode = EM_RELU2; e0.o0 = (bf16_t*)(ar + AR_HID); e0.ldc = FF; ng = 1;
        } else if (tail == 2) {
            g0 = pg8::Gemm{(const bf16_t*)(ar + AR_HID), (const bf16_t*)(ws + WS_MLPW + 32 * MiB), M, 2048, FF, FF, FF, 1 << 20, 0}; e0.mode = EM_RESID; e0.res = Yb; e0.outf = Yb; e0.f0 = stats; e0.p0 = IN(29) + (size_t)(layer * 2) * 2048; e0.p1 = IN(30) + (size_t)(layer * 2) * 2048; e0.ldc = 2048; ng = 1;
        } else if (kind == 0) {
            const int j = layer == 0 ? 0 : 1; unsigned char* wb = ws + WS_MLA_W + (size_t)j * 20 * MiB;
            bf16_t* LAT = (bf16_t*)(ar + AR_LAT); float* PART = (float*)(ar + AR_PART); bf16_t* KROPE = (bf16_t*)(ar + AR_KROPE); bf16_t* Qb = (bf16_t*)(ar + AR_Q);
            bf16_t* KN = (bf16_t*)(ar + AR_KN); bf16_t* VT = (bf16_t*)(ar + AR_VT); bf16_t* Ob = (bf16_t*)(ar + AR_O);
            if (sub == 0) { g0 = pg8::Gemm{HB, (const bf16_t*)wb, M, 1280, 2048, 2048, 2048, 1 << 20, 0}; e0.mode = EM_MLA_IN; e0.o0 = LAT; e0.f0 = PART; e0.o1 = KROPE; e0.tab = tab; ng = 1; }
            else if (sub == 1) { g0 = pg8::Gemm{LAT, (const bf16_t*)(wb + 5 * MiB), M, 3072, 512, 1024, 512, 1 << 20, 0}; e0.mode = EM_MLA_Q; e0.o0 = Qb; e0.f0 = PART; e0.tab = tab; ng = 1; }
            else if (sub == 2) { g0 = pg8::Gemm{LAT + 512, (const bf16_t*)(wb + 8 * MiB), M, 4096, 512, 1024, 512, 1 << 20, 0}; e0.mode = EM_MLA_KV; e0.o0 = KN; e0.o1 = VT; e0.f0 = PART; ng = 1; }
            else if (sub == 3) {
#ifndef NO_MLA
                mla_attn_phase(lds, Qb, KN, KROPE, VT, Ob, G, bx, tid);
#endif
            }
            else { g0 = pg8::Gemm{Ob, (const bf16_t*)(wb + 12 * MiB), M, 2048, 2048, 2048, 2048, 1 << 20, 0}; e0.mode = EM_RESID; e0.res = hres; e0.outf = Yb; e0.f0 = stats; e0.p0 = rg; e0.p1 = rb; e0.ldc = 2048; ng = 1; }
        } else if (kind == 1) {
            bf16_t* X6 = (bf16_t*)(ar + AR_X6); bf16_t* RKV = (bf16_t*)(ar + AR_RKV); bf16_t* LH = (bf16_t*)(ar + AR_LH);
            float* DEC = (float*)(ar + AR_DEC); float* AF = (float*)(ar + AR_AF); bf16_t* GB = (bf16_t*)(ar + AR_GB); bf16_t* YG = (bf16_t*)(ar + AR_YG);
            unsigned char* wb = ws + WS_RW_W;
            if (sub == 0) { g0 = pg8::Gemm{X6, (const bf16_t*)wb, M, 6144, 2048, 2048, 2048, 8, SLOT}; e0.mode = EM_SPLIT; e0.o0 = RKV; ng = 1; }
            else if (sub == 1) { g0 = pg8::Gemm{X6 + 3 * (SLOT / 2), (const bf16_t*)(wb + 24 * MiB), M, 768, 2048, 2048, 2048, 1, SLOT}; e0.mode = EM_LORA_DOWN; e0.o0 = LH; ng = 1; }
            else if (sub == 2) { g0 = pg8::Gemm{LH, (const bf16_t*)(wb + 27 * MiB), M, 6144, 256, 768, 256, 8, 512}; e0.mode = EM_LORA_UP; e0.f0 = DEC; e0.f1 = AF; e0.o0 = GB; e0.p0 = IN(9); e0.p1 = IN(12); ng = 1; }
            else if (sub == 3) {
#ifndef NO_SCAN
                if (G == 256) rwkv_scan_phase(lds, RKV, DEC, AF, IN(17), IN(18), IN(19), (float*)(ar + AR_BON), hout, bx, tid);
#endif
            }
            else if (sub == 4) { rwkv_gn_phase(hout, RKV + 2 * (SLOT / 2), (const float*)(ar + AR_BON), GB, IN(20), IN(21), YG, gw, NGW, lane); }
            else { g0 = pg8::Gemm{YG, (const bf16_t*)(wb + 30 * MiB), M, 2048, 2048, 2048, 2048, 1 << 20, 0}; e0.mode = EM_RESID; e0.res = hres; e0.outf = Yb; e0.f0 = stats; e0.p0 = rg; e0.p1 = rb; e0.ldc = 2048; ng = 1; }
        } else {
            bf16_t* SQ = (bf16_t*)(ar + AR_SQ); bf16_t* SK = (bf16_t*)(ar + AR_SK); bf16_t* SVT = (bf16_t*)(ar + AR_SVT); bf16_t* SO = (bf16_t*)(ar + AR_SO);
            unsigned char* wb = ws + WS_SW_W;
            if (sub == 0) { g0 = pg8::Gemm{HB, (const bf16_t*)wb, M, 2560, 2048, 2048, 2048, 1 << 20, 0}; e0.mode = EM_SWA_QKV; e0.o0 = SQ; e0.o1 = SK; e0.o2 = SVT; e0.bias = IN(24); ng = 1; }
            else if (sub == 1) {
#ifndef NO_SWA
                swa_attn_phase(lds, SQ, SK, SVT, SO, bt2, IN(25), G, bx, tid);
#endif
            }
            else { g0 = pg8::Gemm{SO, (const bf16_t*)(wb + 10 * MiB), M, 2048, 2048, 2048, 2048, 1 << 20, 0}; e0.mode = EM_RESID; e0.res = hres; e0.outf = Yb; e0.f0 = stats; e0.p0 = rg; e0.p1 = rb; e0.bias = IN(27); e0.ldc = 2048; ng = 1; }
        }
#ifndef NO_GEMM
        if (ng) { pg8::StaticOrder S; S.init(g0.M, g0.N, G, bx); pg8::gemm_phase<EpiP>(lds, g0, S, e0, tid); }
#endif
    }
}

extern "C" void kernel_launch(void* const* d_in, const int* in_sizes, int n_in, void* d_out, int out_size, void* d_ws, size_t ws_size, hipStream_t stream) {
    static int grid = 0;
    if (grid == 0) {
        if (n_in != 33 || out_size != M * DM || ws_size < WS_END) { fprintf(stderr, "kernel_launch: unexpected problem (n_in %d, out %d, ws %zu < %zu)\n", n_in, out_size, ws_size, (size_t)WS_END); grid = -1; return; }
        int dev = 0, cus = 0, per_cu = 0;
        hipGetDevice(&dev); hipDeviceGetAttribute(&cus, hipDeviceAttributeMultiprocessorCount, dev);
        if (hipFuncSetAttribute((const void*)hybrid_fwd, hipFuncAttributeMaxDynamicSharedMemorySize, LDS_BYTES) != hipSuccess) { fprintf(stderr, "kernel_launch: hipFuncSetAttribute failed\n"); grid = -1; return; }
        if (hipOccupancyMaxActiveBlocksPerMultiprocessor(&per_cu, (const void*)hybrid_fwd, 512, LDS_BYTES) != hipSuccess || per_cu < 1) { fprintf(stderr, "kernel_launch: occupancy query says %d\n", per_cu); per_cu = 1; }
        (void)hipGetLastError();
        grid = cus;
        fprintf(stderr, "kernel_launch: grid %d (cus %d, per_cu %d)\n", grid, cus, per_cu);
    }
    if (grid < 0) return;
    Args a{};
    for (int i = 0; i < 33; ++i) a.in[i] = (const float*)d_in[i];
    a.out = (float*)d_out; a.ws = (unsigned char*)d_ws;
#ifndef MK_PER_PHASE
    a.ph_lo = 0; a.ph_hi = N_PHASES;
    if (hipMemsetAsync((char*)d_ws + WS_BAR, 0, WS_BAR_BYTES, stream) != hipSuccess) { fprintf(stderr, "kernel_launch: memset of the barrier words failed\n"); return; }
    void* kargs[] = {&a};
    hipError_t e = hipLaunchCooperativeKernel((const void*)hybrid_fwd, dim3(grid), dim3(512), kargs, LDS_BYTES, stream);
    if (e != hipSuccess) fprintf(stderr, "cooperative launch failed: %s (grid %d)\n", hipGetErrorString(e), grid);
#else
    for (int ph = 0; ph < N_PHASES; ++ph) { a.ph_lo = ph; a.ph_hi = ph + 1; hipLaunchKernelGGL(hybrid_fwd, dim3(grid), dim3(512), LDS_BYTES, stream, a); }
#endif
}
```

```cpp
#include <hip/hip_runtime.h>
#include <hip/hip_cooperative_groups.h>
#include <cstdio>
#include <cstdint>
namespace cg = cooperative_groups;

#define GAS __attribute__((address_space(1)))
#define LAS __attribute__((address_space(3)))
typedef unsigned short bf16_t;
typedef short bf16x8 __attribute__((ext_vector_type(8)));
typedef float f32x4 __attribute__((ext_vector_type(4)));
typedef float f32x2 __attribute__((ext_vector_type(2)));
typedef float f32x16 __attribute__((ext_vector_type(16)));
typedef unsigned u32x4 __attribute__((ext_vector_type(4)));
typedef unsigned u32x2 __attribute__((ext_vector_type(2)));

constexpr int M = 16384, DM = 2048, SEQ = 8192, FF = 8192;
constexpr float ALPHA = 1.6817928305074290f;
constexpr float LOG2E = 1.4426950408889634f;
constexpr size_t MiB = 1u << 20;
constexpr size_t WS_TAB = 0;
constexpr size_t WS_BT = 2 * MiB;
constexpr size_t WS_STATS = 3 * MiB;
constexpr size_t WS_BAR = 3 * MiB + 512 * 1024;
constexpr size_t WS_BAR_BYTES = 16384;
constexpr size_t WS_MLA_W = 4 * MiB;
constexpr size_t WS_RW_W = 44 * MiB;
constexpr size_t WS_SW_W = 82 * MiB;
constexpr size_t WS_MLPW = 100 * MiB;
constexpr size_t WS_HB = 164 * MiB;
constexpr size_t WS_Y = 228 * MiB;
constexpr size_t WS_AR = 356 * MiB;
constexpr size_t WS_END = WS_AR + 602 * MiB;
constexpr size_t AR_HID = 0;
constexpr size_t AR_LAT = 0, AR_PART = 32 * MiB, AR_KROPE = 33 * MiB, AR_Q = 36 * MiB, AR_KN = 132 * MiB, AR_VT = 196 * MiB, AR_O = 260 * MiB;
constexpr size_t AR_BON = 600 * MiB;
constexpr size_t AR_X6 = 0, AR_RKV = 384 * MiB, AR_LH = 576 * MiB, AR_DEC = 0, AR_AF = 128 * MiB, AR_GB = 256 * MiB, AR_YG = 320 * MiB;
constexpr size_t AR_SQ = 0, AR_SK = 64 * MiB, AR_SVT = 72 * MiB, AR_SO = 80 * MiB;
constexpr size_t SLOT = (size_t)M * DM * 2;

constexpr int LDS_BYTES = 131072 + 4096;

__device__ __forceinline__ unsigned cvt_pk_bf16(float lo, float hi) { unsigned r; asm volatile("v_cvt_pk_bf16_f32 %0, %1, %2" : "=v"(r) : "v"(lo), "v"(hi)); return r; }
__device__ __forceinline__ float bf2f(unsigned short b) { return __builtin_bit_cast(float, (unsigned)b << 16); }
__device__ __forceinline__ float bflo(unsigned w) { return __builtin_bit_cast(float, w << 16); }
__device__ __forceinline__ float bfhi(unsigned w) { return __builtin_bit_cast(float, w & 0xffff0000u); }
__device__ __forceinline__ u32x4 pack8(f32x4 a, f32x4 b) { u32x4 w; w.x = cvt_pk_bf16(a[0], a[1]); w.y = cvt_pk_bf16(a[2], a[3]); w.z = cvt_pk_bf16(b[0], b[1]); w.w = cvt_pk_bf16(b[2], b[3]); return w; }
__device__ __forceinline__ float wave_sum(float v) {
#pragma unroll
    for (int o = 1; o < 64; o <<= 1) v += __shfl_xor(v, o);
    return v;
}
template <int CTRL> __device__ __forceinline__ float dpp_f(float x) { return __builtin_bit_cast(float, __builtin_amdgcn_update_dpp(0, __builtin_bit_cast(int, x), CTRL, 0xF, 0xF, true)); }
__device__ __forceinline__ float sum16(float x) { x += dpp_f<0xB1>(x); x += dpp_f<0x4E>(x); x += dpp_f<0x141>(x); x += dpp_f<0x140>(x); return x; }
__device__ __forceinline__ float sigmoidf_(float x) { return 1.0f / (1.0f + __expf(-x)); }
__device__ __forceinline__ int crow(int r, int hi) { return (r & 3) + 8 * (r >> 2) + 4 * hi; }

namespace pg8 {
constexpr int BM = 256, BK = 64, HALF = 128, HTB = HALF * BK * 2, STAGE_BYTES = 8 * HTB, NXCD = 8, WGM = 4;
__host__ __device__ __forceinline__ int lds_byte(int r, int c) { const int st = (r >> 4) * 2 + (c >> 5), rr = r & 15, cc = c & 31, ob = rr * 64 + cc * 2; return st * 1024 + (ob ^ (((ob >> 9) & 1) << 5)); }
__host__ __device__ __forceinline__ void stage_rc(int b, int& R, int& C) { const int st = b / 1024, sb = b % 1024, swz = sb ^ (((sb >> 9) & 1) << 5); R = (st >> 1) * 16 + swz / 64; C = (st & 1) * 32 + (swz % 64) / 2; }
__host__ __device__ __forceinline__ int perm32(int rho) { const int n = rho >> 4, i = rho & 15; return 8 * (i >> 2) + 4 * n + (i & 3); }

struct Unit { int pm, pn; };
struct Gemm { const bf16_t* A; const bf16_t* Bt; int M, N, K, lda, ldb, a_group; size_t a_stride; };

struct StaticOrder {
    int nM, nN, nwg, G, c;
    __device__ void init(int M_, int N_, int G_, int c_) { nM = M_ / BM; nN = N_ / BM; nwg = nM * nN; G = G_; c = c_; }
    __device__ bool next(int i, Unit& u) const {
        const long L = (long)i * G + c; if (L >= nwg) return false;
        int wgid = (int)L; { const int q = nwg / NXCD, r = nwg % NXCD, xcd = wgid % NXCD, off = wgid / NXCD; wgid = (xcd < r ? xcd * (q + 1) : r * (q + 1) + (xcd - r) * q) + off; }
        const int wgm = (nN >= 16) ? 8 : 4;
        const int nig = wgm * nN, gid = wgid / nig, fm = gid * wgm, gsz = (nM - fm) < wgm ? (nM - fm) : wgm;
        u.pm = fm + ((wgid % nig) % gsz); u.pn = (wgid % nig) / gsz; return true;
    }
};

template <class Epi>
__device__ __forceinline__ void gemm_phase(LAS unsigned char* lds, const Gemm g, const StaticOrder& S, const Epi& E, const int tid) {
    const int wid = __builtin_amdgcn_readfirstlane(tid >> 6), lane = tid & 63, wr = wid >> 2, wc = wid & 3, fr = lane & 15, fq = lane >> 4;
    const int K = g.K, nt = K / BK;
    unsigned voffA[2], voffB[2];
#pragma unroll
    for (int i = 0; i < 2; ++i) { int R, C; stage_rc(tid * 16 + i * 8192, R, C); const int Rb = (R & ~31) + perm32(R & 31);
        voffA[i] = (unsigned)(R * g.lda + C) * 2u; voffB[i] = (unsigned)(Rb * g.ldb + C) * 2u; }
    const size_t kstep = (size_t)(BK * 2);
    const size_t hstepA = (size_t)HALF * g.lda * 2, hstepB = (size_t)HALF * g.ldb * 2;
    const size_t tstepA = 2 * hstepA, tstepB = 2 * hstepB;
    const unsigned ldsw = (unsigned)wid * 1024u;
    const int aoff = lds_byte(wr * 64 + fr, fq * 8), boff = lds_byte(wc * 32 + fr, fq * 8);
#define PG8_SA(b, h) (((b) * 2 + (h)) * HTB)
#define PG8_SB(b, h) ((4 + (b) * 2 + (h)) * HTB)
#define PG8_STAGE(bufoff, gbase, voff) do { _Pragma("unroll") for (int _i = 0; _i < 2; ++_i) \
        __builtin_amdgcn_global_load_lds((const unsigned*)((const char*)(gbase) + (voff)[_i]), (LAS unsigned*)(lds + (bufoff) + ldsw + _i * 8192), 16, 0, 0); } while (0)
#define PG8_LDA(dst, b, h) do { _Pragma("unroll") for (int m = 0; m < 4; ++m) _Pragma("unroll") for (int k = 0; k < 2; ++k) dst[m][k] = *(const LAS bf16x8*)(lds + PG8_SA(b, h) + aoff + m * 2048 + k * 1024); } while (0)
#define PG8_LDB(dst, b, h) do { _Pragma("unroll") for (int n = 0; n < 2; ++n) _Pragma("unroll") for (int k = 0; k < 2; ++k) dst[n][k] = *(const LAS bf16x8*)(lds + PG8_SB(b, h) + boff + n * 2048 + k * 1024); } while (0)
#define PG8_MMA(ai, bj, At, Bt) do { __builtin_amdgcn_s_setprio(1); _Pragma("unroll") for (int m = 0; m < 4; ++m) _Pragma("unroll") for (int n = 0; n < 2; ++n) _Pragma("unroll") for (int k = 0; k < 2; ++k) \
        acc[ai][bj][m][n] = __builtin_amdgcn_mfma_f32_16x16x32_bf16(Bt[n][k], At[m][k], acc[ai][bj][m][n], 0, 0, 0); __builtin_amdgcn_s_setprio(0); } while (0)
#define PG8_WAIT_V(n) asm volatile("s_waitcnt vmcnt(" #n ")" ::: "memory")
#define PG8_WAIT_L(n) asm volatile("s_waitcnt lgkmcnt(" #n ")" ::: "memory")
#define PG8_BAR __builtin_amdgcn_s_barrier()
#define PG8_SCHED __builtin_amdgcn_sched_barrier(0)
    Unit cur, nxt; int ui = 0;
    if (!S.next(0, cur)) return;
    f32x4 acc[2][2][4][2];
#pragma unroll
    for (int a = 0; a < 2; ++a)
#pragma unroll
        for (int b = 0; b < 2; ++b)
#pragma unroll
            for (int m = 0; m < 4; ++m)
#pragma unroll
                for (int n = 0; n < 2; ++n) acc[a][b][m][n] = (f32x4){0.f, 0.f, 0.f, 0.f};
    bf16x8 At[4][2], B0[2][2], B1[2][2];
    const char* cA = (const char*)g.A + (size_t)cur.pm * tstepA + (size_t)(cur.pn / g.a_group) * g.a_stride; const char* cB = (const char*)g.Bt + (size_t)cur.pn * tstepB;
    PG8_STAGE(PG8_SB(0, 0), cB, voffB); PG8_STAGE(PG8_SB(0, 1), cB + hstepB, voffB); PG8_STAGE(PG8_SA(0, 0), cA, voffA); PG8_STAGE(PG8_SA(0, 1), cA + hstepA, voffA);
    if (wr == 1) PG8_BAR;
    PG8_WAIT_V(2); PG8_BAR;
    PG8_STAGE(PG8_SB(1, 0), cB + kstep, voffB); PG8_STAGE(PG8_SA(1, 0), cA + kstep, voffA); PG8_STAGE(PG8_SB(1, 1), cB + hstepB + kstep, voffB);
    PG8_WAIT_V(6); PG8_BAR;
    for (;;) {
        const bool has_next = S.next(ui + 1, nxt);
        const char* nA = has_next ? (const char*)g.A + (size_t)nxt.pm * tstepA + (size_t)(nxt.pn / g.a_group) * g.a_stride : cA; const char* nB = has_next ? (const char*)g.Bt + (size_t)nxt.pn * tstepB : cB;
        for (int t = 0; t < nt; t += 2) {
            const bool last = (t == nt - 2);
            const char* a1 = cA + (size_t)(t + 1) * kstep;
            const char* a2 = last ? nA : cA + (size_t)(t + 2) * kstep; const char* b2 = last ? nB : cB + (size_t)(t + 2) * kstep;
            const char* a3 = a2 + kstep; const char* b3 = b2 + kstep;
            PG8_LDB(B0, 0, 0); PG8_LDB(B1, 0, 1); PG8_SCHED; PG8_LDA(At, 0, 0); PG8_STAGE(PG8_SA(1, 1), a1 + hstepA, voffA);
            PG8_WAIT_V(8); PG8_WAIT_L(0); PG8_BAR; PG8_MMA(0, 0, At, B0); PG8_MMA(0, 1, At, B1); PG8_BAR; PG8_SCHED;
            PG8_LDA(At, 0, 1); PG8_STAGE(PG8_SB(0, 0), b2, voffB); PG8_STAGE(PG8_SB(0, 1), b2 + hstepB, voffB); PG8_STAGE(PG8_SA(0, 0), a2, voffA);
            PG8_WAIT_V(8); PG8_WAIT_L(0); PG8_BAR; PG8_MMA(1, 0, At, B0); PG8_MMA(1, 1, At, B1); PG8_BAR; PG8_SCHED;
            PG8_LDB(B0, 1, 0); PG8_LDB(B1, 1, 1); PG8_SCHED; PG8_LDA(At, 1, 0); PG8_STAGE(PG8_SA(0, 1), a2 + hstepA, voffA);
            PG8_WAIT_V(8); PG8_WAIT_L(0); PG8_BAR; PG8_MMA(0, 0, At, B0); PG8_MMA(0, 1, At, B1); PG8_BAR; PG8_SCHED;
            PG8_LDA(At, 1, 1); PG8_STAGE(PG8_SB(1, 0), b3, voffB); PG8_STAGE(PG8_SB(1, 1), b3 + hstepB, voffB); PG8_STAGE(PG8_SA(1, 0), a3, voffA);
            PG8_WAIT_V(8); PG8_WAIT_L(0); PG8_BAR; PG8_MMA(1, 0, At, B0); PG8_MMA(1, 1, At, B1); PG8_BAR; PG8_SCHED;
        }
        if (wr == 0) PG8_BAR;
        E(acc, cur, wr, wc, fr, fq);
        if (!has_next) break;
#pragma unroll
        for (int a = 0; a < 2; ++a)
#pragma unroll
            for (int b = 0; b < 2; ++b)
#pragma unroll
                for (int m = 0; m < 4; ++m)
#pragma unroll
                    for (int n = 0; n < 2; ++n) acc[a][b][m][n] = (f32x4){0.f, 0.f, 0.f, 0.f};
        cur = nxt; cA = nA; cB = nB; ++ui;
        if (wr == 1) PG8_BAR;
    }
    PG8_WAIT_V(0);
    PG8_BAR;
#undef PG8_SA
#undef PG8_SB
#undef PG8_STAGE
#undef PG8_LDA
#undef PG8_LDB
#undef PG8_MMA
#undef PG8_WAIT_V
#undef PG8_WAIT_L
#undef PG8_BAR
#undef PG8_SCHED
}
}

enum EpiMode { EM_RESID = 0, EM_RELU2, EM_SPLIT, EM_LORA_DOWN, EM_LORA_UP, EM_SWA_QKV, EM_MLA_IN, EM_MLA_Q, EM_MLA_KV };
struct EpiP {
    int mode;
    const float* res; const float* bias; float* outf;
    bf16_t* o0; bf16_t* o1; bf16_t* o2;
    float* f0; float* f1;
    const float* p0; const float* p1;
    const float* tab;
    int ldc;
    __device__ __forceinline__ void operator()(const f32x4 (&acc)[2][2][4][2], const pg8::Unit& u, int wr, int wc, int fr, int fq) const {
        const int row0 = u.pm * 256 + wr * 64 + fr, colb = u.pn * 256 + wc * 32 + 8 * fq;
#define EPI_BEGIN _Pragma("unroll") for (int ai = 0; ai < 2; ++ai) _Pragma("unroll") for (int m = 0; m < 4; ++m) { const int row = row0 + ai * 128 + m * 16; \
        _Pragma("unroll") for (int bj = 0; bj < 2; ++bj) { const int col = colb + bj * 128; f32x4 v0 = acc[ai][bj][m][0], v1 = acc[ai][bj][m][1];
#define EPI_END } asm volatile("" ::: "memory"); }
        if (mode == EM_RESID) {
            EPI_BEGIN { const size_t off = (size_t)row * ldc + col; f32x4 r0 = *(const f32x4*)(res + off), r1 = *(const f32x4*)(res + off + 4);
                if (p0) { const f32x2 ms = *(const f32x2*)(f0 + 2 * (size_t)row); const f32x4 g0 = *(const f32x4*)(p0 + col), g1 = *(const f32x4*)(p0 + col + 4), b0 = *(const f32x4*)(p1 + col), b1 = *(const f32x4*)(p1 + col + 4);
                    r0 = (r0 - ms[0]) * ms[1] * g0 + b0; r1 = (r1 - ms[0]) * ms[1] * g1 + b1; }
                if (bias) { v0 += *(const f32x4*)(bias + col); v1 += *(const f32x4*)(bias + col + 4); }
                *(f32x4*)(outf + off) = r0 * ALPHA + v0; *(f32x4*)(outf + off + 4) = r1 * ALPHA + v1; } EPI_END
        } else if (mode == EM_RELU2) {
            EPI_BEGIN { const f32x4 z = {0.f, 0.f, 0.f, 0.f}; v0 = __builtin_elementwise_max(v0, z); v1 = __builtin_elementwise_max(v1, z); v0 = v0 * v0; v1 = v1 * v1;
                *(u32x4*)(o0 + (size_t)row * ldc + col) = pack8(v0, v1); } EPI_END
        } else if (mode == EM_SPLIT) {
            EPI_BEGIN { const int s = col >> 11, c = col & 2047; *(u32x4*)(o0 + (size_t)s * (SLOT / 2) + (size_t)row * 2048 + c) = pack8(v0, v1); } EPI_END
        } else if (mode == EM_LORA_DOWN) {
            const int pn = u.pn;
            EPI_BEGIN {
                if (pn == 0) {
#pragma unroll
                    for (int e = 0; e < 4; ++e) { v0[e] = 1.0f - 2.0f / (1.0f + __expf(2.0f * v0[e])); v1[e] = 1.0f - 2.0f / (1.0f + __expf(2.0f * v1[e])); }
                } else if (pn == 2) {
#pragma unroll
                    for (int e = 0; e < 4; ++e) { v0[e] = sigmoidf_(v0[e]); v1[e] = sigmoidf_(v1[e]); }
                }
                *(u32x4*)(o0 + (size_t)row * 768 + col) = pack8(v0, v1); } EPI_END
        } else if (mode == EM_LORA_UP) {
            const int grp = u.pn >> 3;
            EPI_BEGIN { const int c = col & 2047; const size_t off = (size_t)row * 2048 + c;
                if (grp == 0) { const f32x4 b0 = *(const f32x4*)(p0 + c), b1 = *(const f32x4*)(p0 + c + 4);
#pragma unroll
                    for (int e = 0; e < 4; ++e) { v0[e] = __expf(-0.6065306597126334f * sigmoidf_(v0[e] + b0[e])); v1[e] = __expf(-0.6065306597126334f * sigmoidf_(v1[e] + b1[e])); }
                    *(f32x4*)(f0 + off) = v0; *(f32x4*)(f0 + off + 4) = v1;
                } else if (grp == 1) { const f32x4 b0 = *(const f32x4*)(p1 + c), b1 = *(const f32x4*)(p1 + c + 4);
#pragma unroll
                    for (int e = 0; e < 4; ++e) { v0[e] = sigmoidf_(v0[e] + b0[e]); v1[e] = sigmoidf_(v1[e] + b1[e]); }
                    *(f32x4*)(f1 + off) = v0; *(f32x4*)(f1 + off + 4) = v1;
                } else { *(u32x4*)(o0 + off) = pack8(v0, v1); } } EPI_END
        } else if (mode == EM_SWA_QKV) {
            const float qs = 0.125f * LOG2E;
            EPI_BEGIN { v0 += *(const f32x4*)(bias + col); v1 += *(const f32x4*)(bias + col + 4);
                if (col < 2048) { *(u32x4*)(o0 + (size_t)row * 2048 + col) = pack8(v0 * qs, v1 * qs); }
                else if (col < 2304) { *(u32x4*)(o1 + (size_t)row * 256 + (col - 2048)) = pack8(v0, v1); }
                else { const int d = col - 2304, b = row >> 13, t = row & 8191; bf16_t* vp = o2 + ((size_t)(b * 256 + d)) * 8192 + t; const u32x4 w = pack8(v0, v1);
                    vp[0] = (bf16_t)(w.x & 0xffff); vp[8192] = (bf16_t)(w.x >> 16); vp[2 * 8192] = (bf16_t)(w.y & 0xffff); vp[3 * 8192] = (bf16_t)(w.y >> 16);
                    vp[4 * 8192] = (bf16_t)(w.z & 0xffff); vp[5 * 8192] = (bf16_t)(w.z >> 16); vp[6 * 8192] = (bf16_t)(w.w & 0xffff); vp[7 * 8192] = (bf16_t)(w.w >> 16); } } EPI_END
        } else if (mode == EM_MLA_IN) {
            const int pn = u.pn;
#pragma unroll
            for (int ai = 0; ai < 2; ++ai)
#pragma unroll
                for (int m = 0; m < 4; ++m) { const int row = row0 + ai * 128 + m * 16;
                    if (pn < 4) { float ss = 0.f;
#pragma unroll
                        for (int bj = 0; bj < 2; ++bj) { const int col = colb + bj * 128; const f32x4 v0 = acc[ai][bj][m][0], v1 = acc[ai][bj][m][1];
                            ss += (v0[0] * v0[0] + v0[1] * v0[1]) + (v0[2] * v0[2] + v0[3] * v0[3]) + (v1[0] * v1[0] + v1[1] * v1[1]) + (v1[2] * v1[2] + v1[3] * v1[3]);
                            *(u32x4*)(o0 + (size_t)row * 1024 + col) = pack8(v0, v1); }
                        ss += __shfl_xor(ss, 16); ss += __shfl_xor(ss, 32);
                        if (fq == 0) f0[(size_t)row * 16 + pn * 4 + wc] = ss;
                    } else if (wc < 2) {
                        const f32x4 v0 = acc[ai][0][m][0], v1 = acc[ai][0][m][1]; const int pos = row & 8191, i0 = 16 * wc + 4 * fq;
                        const f32x4 t0 = *(const f32x4*)(tab + ((size_t)pos * 32 + i0) * 2), t1 = *(const f32x4*)(tab + ((size_t)pos * 32 + i0) * 2 + 4);
                        const float a0 = v0[0] * t0[0] - v0[1] * t0[1], b0 = v0[1] * t0[0] + v0[0] * t0[1];
                        const float a1 = v0[2] * t0[2] - v0[3] * t0[3], b1 = v0[3] * t0[2] + v0[2] * t0[3];
                        const float a2 = v1[0] * t1[0] - v1[1] * t1[1], b2 = v1[1] * t1[0] + v1[0] * t1[1];
                        const float a3 = v1[2] * t1[2] - v1[3] * t1[3], b3 = v1[3] * t1[2] + v1[2] * t1[3];
                        u32x2 wa, wb; wa.x = cvt_pk_bf16(a0, a1); wa.y = cvt_pk_bf16(a2, a3); wb.x = cvt_pk_bf16(b0, b1); wb.y = cvt_pk_bf16(b2, b3);
                        *(u32x2*)(o1 + (size_t)row * 64 + i0) = wa; *(u32x2*)(o1 + (size_t)row * 64 + 32 + i0) = wb; }
                    asm volatile("" ::: "memory");
                }
        } else if (mode == EM_MLA_Q) {
            const int pn = u.pn; const float qsc = 0.07216878364870322f * LOG2E;
#pragma unroll
            for (int ai = 0; ai < 2; ++ai)
#pragma unroll
                for (int m = 0; m < 4; ++m) { const int row = row0 + ai * 128 + m * 16;
                    const f32x4 pa = *(const f32x4*)(f0 + (size_t)row * 16), pb = *(const f32x4*)(f0 + (size_t)row * 16 + 4);
                    const float ssq = ((pa[0] + pa[1]) + (pa[2] + pa[3])) + ((pb[0] + pb[1]) + (pb[2] + pb[3]));
                    const float sc = qsc / sqrtf(ssq * (1.0f / 512.0f) + 1e-6f);
#pragma unroll
                    for (int bj = 0; bj < 2; ++bj) { const int col = colb + bj * 128; const f32x4 v0 = acc[ai][bj][m][0] * sc, v1 = acc[ai][bj][m][1] * sc;
                        if (pn < 8) { const int h = col >> 7, d = col & 127; *(u32x4*)(o0 + (size_t)row * 3072 + h * 192 + d) = pack8(v0, v1); }
                        else { const int j = col - 2048, h = j >> 6, i0 = (j & 63) >> 1, pos = row & 8191;
                            const f32x4 t0 = *(const f32x4*)(tab + ((size_t)pos * 32 + i0) * 2), t1 = *(const f32x4*)(tab + ((size_t)pos * 32 + i0) * 2 + 4);
                            const float a0 = v0[0] * t0[0] - v0[1] * t0[1], b0 = v0[1] * t0[0] + v0[0] * t0[1];
                            const float a1 = v0[2] * t0[2] - v0[3] * t0[3], b1 = v0[3] * t0[2] + v0[2] * t0[3];
                            const float a2 = v1[0] * t1[0] - v1[1] * t1[1], b2 = v1[1] * t1[0] + v1[0] * t1[1];
                            const float a3 = v1[2] * t1[2] - v1[3] * t1[3], b3 = v1[3] * t1[2] + v1[2] * t1[3];
                            u32x2 wa, wb; wa.x = cvt_pk_bf16(a0, a1); wa.y = cvt_pk_bf16(a2, a3); wb.x = cvt_pk_bf16(b0, b1); wb.y = cvt_pk_bf16(b2, b3);
                            bf16_t* qp = o0 + (size_t)row * 3072 + h * 192 + 128 + i0; *(u32x2*)qp = wa; *(u32x2*)(qp + 32) = wb; } }
                    asm volatile("" ::: "memory");
                }
        } else {
            const int h = u.pn;
#pragma unroll
            for (int ai = 0; ai < 2; ++ai)
#pragma unroll
                for (int m = 0; m < 4; ++m) { const int row = row0 + ai * 128 + m * 16;
                    const f32x4 pa = *(const f32x4*)(f0 + (size_t)row * 16 + 8), pb = *(const f32x4*)(f0 + (size_t)row * 16 + 12);
                    const float ssq = ((pa[0] + pa[1]) + (pa[2] + pa[3])) + ((pb[0] + pb[1]) + (pb[2] + pb[3]));
                    const float sc = 1.0f / sqrtf(ssq * (1.0f / 512.0f) + 1e-6f);
                    { const f32x4 v0 = acc[ai][0][m][0] * sc, v1 = acc[ai][0][m][1] * sc; *(u32x4*)(o0 + (size_t)row * 2048 + h * 128 + wc * 32 + 8 * fq) = pack8(v0, v1); }
                    { const f32x4 v0 = acc[ai][1][m][0] * sc, v1 = acc[ai][1][m][1] * sc; const int b = row >> 13, t = row & 8191, dv = wc * 32 + 8 * fq;
                        bf16_t* vp = o1 + ((size_t)((b * 16 + h) * 128 + dv)) * 8192 + t; const u32x4 w = pack8(v0, v1);
                        vp[0] = (bf16_t)(w.x & 0xffff); vp[8192] = (bf16_t)(w.x >> 16); vp[2 * 8192] = (bf16_t)(w.y & 0xffff); vp[3 * 8192] = (bf16_t)(w.y >> 16);
                        vp[4 * 8192] = (bf16_t)(w.z & 0xffff); vp[5 * 8192] = (bf16_t)(w.z >> 16); vp[6 * 8192] = (bf16_t)(w.w & 0xffff); vp[7 * 8192] = (bf16_t)(w.w >> 16); }
                    asm volatile("" ::: "memory");
                }
        }
#undef EPI_BEGIN
#undef EPI_END
    }
};

__device__ __forceinline__ int colmap(int kind, int n, int Nsrc) {
    if (kind == 1) { if (n < 1024) return n; if (n >= 1088) return -1; const int j = n - 1024; return 1024 + (j >> 1) + 32 * (j & 1); }
    if (kind == 2) { if (n < 2048) return (n >> 7) * 192 + (n & 127); const int j = n - 2048, h = j >> 6, jj = j & 63; return h * 192 + 128 + (jj >> 1) + 32 * (jj & 1); }
    return n < Nsrc ? n : -1;
}
__device__ __forceinline__ void transpose_w(const float* W, int Ksrc, int Nsrc, bf16_t* WT, int ldwt, int Ndst, int kind, const float* rscale, LAS float* scr, int gw, int NGW, int lane) {
    const int nblk = Ndst / 64, nitems = (Ksrc / 64) * nblk;
    const int nl = (lane & 15) * 4, kr = lane >> 4, c = lane & 7;
    if (kind == 0 && Ndst <= Nsrc) {
        f32x4 cur[16], nxt[16];
        int item = gw;
        if (item < nitems) { const int k0 = 64 * (item / nblk), n0 = 64 * (item % nblk);
#pragma unroll
            for (int i = 0; i < 16; ++i) cur[i] = *(const f32x4*)(W + (size_t)(k0 + 4 * i + kr) * Nsrc + n0 + nl); }
        for (; item < nitems; item += NGW) {
            const int k0 = 64 * (item / nblk), n0 = 64 * (item % nblk); const int nit = item + NGW;
            if (nit < nitems) { const int k1 = 64 * (nit / nblk), n1 = 64 * (nit % nblk);
#pragma unroll
                for (int i = 0; i < 16; ++i) nxt[i] = *(const f32x4*)(W + (size_t)(k1 + 4 * i + kr) * Nsrc + n1 + nl); }
#pragma unroll
            for (int i = 0; i < 16; ++i) { const int kk = 4 * i + kr; f32x4 v = cur[i]; if (rscale) v = v * rscale[k0 + kk];
                LAS float* d = scr + kk * 65 + nl; d[0] = v[0]; d[1] = v[1]; d[2] = v[2]; d[3] = v[3]; }
            asm volatile("s_waitcnt lgkmcnt(0)" ::: "memory");
#pragma unroll
            for (int j = 0; j < 8; ++j) { const int n = (lane >> 3) + 8 * j; const LAS float* sp = scr + (8 * c) * 65 + n;
                u32x4 o; o.x = cvt_pk_bf16(sp[0 * 65], sp[1 * 65]); o.y = cvt_pk_bf16(sp[2 * 65], sp[3 * 65]); o.z = cvt_pk_bf16(sp[4 * 65], sp[5 * 65]); o.w = cvt_pk_bf16(sp[6 * 65], sp[7 * 65]);
                *(u32x4*)(WT + (size_t)(n0 + n) * ldwt + k0 + 8 * c) = o; }
            asm volatile("s_waitcnt lgkmcnt(0)" ::: "memory");
#pragma unroll
            for (int i = 0; i < 16; ++i) cur[i] = nxt[i];
        }
        return;
    }
    for (int item = gw; item < nitems; item += NGW) {
        const int kb = item / nblk, nb = item % nblk, k0 = 64 * kb, n0 = 64 * nb;
        if (kind == 0 && n0 + 64 <= Nsrc) {
#pragma unroll 4
            for (int i = 0; i < 16; ++i) { const int kk = 4 * i + kr; f32x4 v = *(const f32x4*)(W + (size_t)(k0 + kk) * Nsrc + n0 + nl); if (rscale) v = v * rscale[k0 + kk];
                LAS float* d = scr + kk * 65 + nl; d[0] = v[0]; d[1] = v[1]; d[2] = v[2]; d[3] = v[3]; }
        } else {
            int src[4];
#pragma unroll
            for (int e = 0; e < 4; ++e) src[e] = colmap(kind, n0 + nl + e, Nsrc);
#pragma unroll 4
            for (int i = 0; i < 16; ++i) { const int kk = 4 * i + kr; const float rs = rscale ? rscale[k0 + kk] : 1.0f; LAS float* d = scr + kk * 65 + nl;
#pragma unroll
                for (int e = 0; e < 4; ++e) d[e] = (src[e] >= 0) ? W[(size_t)(k0 + kk) * Nsrc + src[e]] * rs : 0.f; }
        }
        asm volatile("s_waitcnt lgkmcnt(0)" ::: "memory");
#pragma unroll
        for (int j = 0; j < 8; ++j) { const int n = (lane >> 3) + 8 * j; const LAS float* sp = scr + (8 * c) * 65 + n;
            u32x4 o; o.x = cvt_pk_bf16(sp[0 * 65], sp[1 * 65]); o.y = cvt_pk_bf16(sp[2 * 65], sp[3 * 65]); o.z = cvt_pk_bf16(sp[4 * 65], sp[5 * 65]); o.w = cvt_pk_bf16(sp[6 * 65], sp[7 * 65]);
            *(u32x4*)(WT + (size_t)(n0 + n) * ldwt + k0 + 8 * c) = o; }
        asm volatile("s_waitcnt lgkmcnt(0)" ::: "memory");
    }
}
__device__ __forceinline__ void transpose_small(const float* W, bf16_t* WT, int gt, int NGT) {
    for (int idx = gt; idx < 2048 * 32; idx += NGT) { const int n = idx >> 5, k0 = (idx & 31) * 8; float v[8];
#pragma unroll
        for (int e = 0; e < 8; ++e) v[e] = (k0 + e < 96) ? W[(size_t)(k0 + e) * 2048 + n] : 0.f;
        u32x4 o; o.x = cvt_pk_bf16(v[0], v[1]); o.y = cvt_pk_bf16(v[2], v[3]); o.z = cvt_pk_bf16(v[4], v[5]); o.w = cvt_pk_bf16(v[6], v[7]);
        *(u32x4*)(WT + (size_t)n * 256 + k0) = o; }
}
__device__ __forceinline__ void rope_cs(int pos, int i, float& c, float& s) {
    const float fi = (float)i, ph = fi * 0.415241003036499f, pe = __builtin_fmaf(fi, 0.415241003036499f, -ph) + fi * 8.82442119376492e-09f;
    const float inv0 = __builtin_amdgcn_exp2f(-ph), inv = inv0 - inv0 * 0.69314718f * pe;
    const float fp = (float)pos, p = fp * inv, pe2 = __builtin_fmaf(fp, inv, -p);
    const float kq = __builtin_rintf(p * 0.636619772f); const int q = (int)kq;
    float r = __builtin_fmaf(-kq, 1.5707963705062866f, p); r = __builtin_fmaf(-kq, -4.371138828673793e-08f, r); r += pe2;
    const float r2 = r * r;
    float sp = 2.7557319e-06f; sp = sp * r2 - 1.9841270e-04f; sp = sp * r2 + 8.3333333e-03f; sp = sp * r2 - 1.6666667e-01f;
    const float sn = r + r * r2 * sp;
    float cp = -2.7557319e-07f; cp = cp * r2 + 2.4801587e-05f; cp = cp * r2 - 1.3888889e-03f; cp = cp * r2 + 4.1666667e-02f; cp = cp * r2 - 0.5f;
    const float cs = 1.0f + r2 * cp;
    const int qq = q & 3;
    c = (qq == 0) ? cs : (qq == 1) ? -sn : (qq == 2) ? -cs : sn;
    s = (qq == 0) ? sn : (qq == 1) ? cs : (qq == 2) ? -sn : -cs;
}
__device__ __forceinline__ float wave_sum2(float v) { v = sum16(v); v += __shfl_xor(v, 16); v += __shfl_xor(v, 32); return v; }
__device__ __forceinline__ void ln_rows4(const float* y0, const float* g, const float* b, float* h0, bf16_t* hb0, float* st0, bool final, int lane) {
    const f32x4* yr = (const f32x4*)y0 + lane; f32x4 v[4][8]; float s[4], q[4], mu[4], rs[4];
#pragma unroll
    for (int i = 0; i < 4; ++i)
#pragma unroll
        for (int j = 0; j < 8; ++j) v[i][j] = yr[512 * i + 64 * j];
#pragma unroll
    for (int i = 0; i < 4; ++i) { s[i] = 0.f;
#pragma unroll
        for (int j = 0; j < 8; ++j) s[i] += (v[i][j][0] + v[i][j][1]) + (v[i][j][2] + v[i][j][3]); }
#pragma unroll
    for (int i = 0; i < 4; ++i) mu[i] = wave_sum2(s[i]) * (1.f / 2048.f);
#pragma unroll
    for (int i = 0; i < 4; ++i) { q[i] = 0.f;
#pragma unroll
        for (int j = 0; j < 8; ++j) { v[i][j] = v[i][j] - mu[i]; q[i] += (v[i][j][0] * v[i][j][0] + v[i][j][1] * v[i][j][1]) + (v[i][j][2] * v[i][j][2] + v[i][j][3] * v[i][j][3]); } }
#pragma unroll
    for (int i = 0; i < 4; ++i) rs[i] = 1.0f / sqrtf(wave_sum2(q[i]) * (1.f / 2048.f) + 1e-5f);
    if (!final && lane == 0) { *(f32x4*)st0 = (f32x4){mu[0], rs[0], mu[1], rs[1]}; *(f32x4*)(st0 + 4) = (f32x4){mu[2], rs[2], mu[3], rs[3]}; }
#pragma unroll
    for (int j = 0; j < 8; ++j) { const f32x4 gg = ((const f32x4*)g)[lane + 64 * j], bb = ((const f32x4*)b)[lane + 64 * j];
#pragma unroll
        for (int i = 0; i < 4; ++i) { const f32x4 o = v[i][j] * rs[i] * gg + bb;
            if (final) ((f32x4*)h0)[512 * i + lane + 64 * j] = o;
            else { u32x2 w; w.x = cvt_pk_bf16(o[0], o[1]); w.y = cvt_pk_bf16(o[2], o[3]); ((u32x2*)hb0)[512 * i + lane + 64 * j] = w; } } }
}

__device__ __forceinline__ void ln_mix_rows4(const float* y0, int row0, const float* g, const float* b, const float* mix, bf16_t* X6, float* st0, int lane) {
    asm volatile("" : "+v"(lane));
    const f32x4* yr = (const f32x4*)y0 + lane;
    const bool has_prev = (row0 & 8191) != 0; float mp = 0.f, rp = 0.f;
    if (has_prev) { float s = 0.f, q = 0.f; f32x4 t[8];
#pragma unroll
        for (int j = 0; j < 8; ++j) { t[j] = yr[64 * j - 512]; s += (t[j][0] + t[j][1]) + (t[j][2] + t[j][3]); }
        mp = wave_sum2(s) * (1.f / 2048.f);
#pragma unroll
        for (int j = 0; j < 8; ++j) { t[j] = t[j] - mp; q += (t[j][0] * t[j][0] + t[j][1] * t[j][1]) + (t[j][2] * t[j][2] + t[j][3] * t[j][3]); }
        rp = 1.0f / sqrtf(wave_sum2(q) * (1.f / 2048.f) + 1e-5f); }
    asm volatile("" ::: "memory");
    f32x4 v[4][8]; float s[4], q[4], mu[4], rs[4];
#pragma unroll
    for (int i = 0; i < 4; ++i)
#pragma unroll
        for (int j = 0; j < 8; ++j) v[i][j] = yr[512 * i + 64 * j];
#pragma unroll
    for (int i = 0; i < 4; ++i) { s[i] = 0.f;
#pragma unroll
        for (int j = 0; j < 8; ++j) s[i] += (v[i][j][0] + v[i][j][1]) + (v[i][j][2] + v[i][j][3]); }
#pragma unroll
    for (int i = 0; i < 4; ++i) mu[i] = wave_sum2(s[i]) * (1.f / 2048.f);
#pragma unroll
    for (int i = 0; i < 4; ++i) { q[i] = 0.f;
#pragma unroll
        for (int j = 0; j < 8; ++j) { v[i][j] = v[i][j] - mu[i]; q[i] += (v[i][j][0] * v[i][j][0] + v[i][j][1] * v[i][j][1]) + (v[i][j][2] * v[i][j][2] + v[i][j][3] * v[i][j][3]); } }
#pragma unroll
    for (int i = 0; i < 4; ++i) rs[i] = 1.0f / sqrtf(wave_sum2(q[i]) * (1.f / 2048.f) + 1e-5f);
    if (lane == 0) { *(f32x4*)st0 = (f32x4){mu[0], rs[0], mu[1], rs[1]}; *(f32x4*)(st0 + 4) = (f32x4){mu[2], rs[2], mu[3], rs[3]}; }
#pragma unroll
    for (int j = 0; j < 8; ++j) { int pc = lane + 64 * j; asm volatile("" : "+v"(pc)); const f32x4 gg = ((const f32x4*)g)[pc], bb = ((const f32x4*)b)[pc];
        f32x4 hp = {0.f, 0.f, 0.f, 0.f}; if (has_prev) hp = (yr[64 * j - 512] - mp) * rp * gg + bb;
        f32x4 h[4];
#pragma unroll
        for (int i = 0; i < 4; ++i) h[i] = v[i][j] * rs[i] * gg + bb;
#pragma unroll
        for (int sl = 0; sl < 6; ++sl) { const int mr = (sl == 0) ? 0 : (sl == 1) ? 2 : (sl == 2) ? 3 : (sl == 3) ? 1 : sl; const f32x4 m4 = ((const f32x4*)(mix + mr * 2048))[pc];
#pragma unroll
            for (int i = 0; i < 4; ++i) { const f32x4 pv = (i == 0) ? hp : h[i - 1]; const f32x4 o = h[i] + (pv - h[i]) * m4;
                u32x2 w; w.x = cvt_pk_bf16(o[0], o[1]); w.y = cvt_pk_bf16(o[2], o[3]);
                ((u32x2*)(X6 + (size_t)sl * (SLOT / 2) + (size_t)(row0 + i) * 2048))[pc] = w; } }
        asm volatile("" ::: "memory"); }
}

constexpr int MK_STRIDE = 400, MV_STRIDE = 144, MK_BYTES = 64 * MK_STRIDE, MV_BYTES = 128 * MV_STRIDE, MBUF = MK_BYTES + MV_BYTES;
__device__ __forceinline__ void mla_attn_phase(LAS unsigned char* lds, const bf16_t* Q, const bf16_t* KN, const bf16_t* KR, const bf16_t* VT, bf16_t* O, int G, int bx, const int tid) {
    const int lane = tid & 63, wid = __builtin_amdgcn_readfirstlane(tid >> 6), r32 = lane & 31, hi = lane >> 5;
    const int vcu = (G % 8 == 0) ? (bx % 8) * (G / 8) + bx / 8 : bx;
    for (int ui = 0;; ++ui) {
        int bh, qb;
        if (G == 256) { if (ui >= 4) break; const int s = vcu & 7; bh = vcu >> 3; qb = (ui == 0) ? s : (ui == 1) ? 15 - s : (ui == 2) ? 16 + s : 31 - s; }
        else { const int L = ui * G + bx; if (L >= 1024) break; bh = L & 31; qb = 31 - (L >> 5); }
        const int b = bh >> 4, h = bh & 15; const size_t rowbase = (size_t)b * SEQ; const int q0 = qb * 256 + wid * 32;
        bf16x8 qf[12];
        { const bf16_t* qp = Q + (rowbase + q0 + r32) * 3072 + h * 192 + hi * 8;
#pragma unroll
            for (int d0 = 0; d0 < 12; ++d0) qf[d0] = *(const bf16x8*)(qp + d0 * 16); }
        const int NT = 4 * (qb + 1);
        f32x16 o[4];
#pragma unroll
        for (int i = 0; i < 4; ++i)
#pragma unroll
            for (int r = 0; r < 16; ++r) o[i][r] = 0.f;
        float mrun = -1e30f, lrun = 0.f;
        u32x4 kreg[3], vreg[2];
        const int kkey = tid >> 4, kpc = tid & 15, rkey = tid >> 3, rpc = tid & 7;
        const bf16_t* kn0 = KN + (rowbase + kkey) * 2048 + h * 128 + kpc * 8;
        const bf16_t* kr0 = KR + (rowbase + rkey) * 64 + rpc * 8;
        const bf16_t* vt0 = VT + ((size_t)(bh * 128 + (tid >> 3))) * 8192 + (tid & 7) * 8;
#define MLA_LOAD(j) do { kreg[0] = *(const u32x4*)(kn0 + (size_t)(64 * (j)) * 2048); kreg[1] = *(const u32x4*)(kn0 + (size_t)(64 * (j) + 32) * 2048); kreg[2] = *(const u32x4*)(kr0 + (size_t)(64 * (j)) * 64); \
        vreg[0] = *(const u32x4*)(vt0 + 64 * (j)); vreg[1] = *(const u32x4*)(vt0 + (size_t)64 * 8192 + 64 * (j)); } while (0)
#define MLA_STORE(buf) do { LAS unsigned char* kb_ = lds + (buf) * MBUF; LAS unsigned char* vb_ = kb_ + MK_BYTES; \
        *(LAS u32x4*)(kb_ + kkey * MK_STRIDE + kpc * 16) = kreg[0]; *(LAS u32x4*)(kb_ + (kkey + 32) * MK_STRIDE + kpc * 16) = kreg[1]; *(LAS u32x4*)(kb_ + rkey * MK_STRIDE + 256 + rpc * 16) = kreg[2]; \
        { LAS unsigned char* p_ = vb_ + (tid >> 3) * MV_STRIDE + ((tid & 7) >> 1) * 32 + (tid & 1) * 8; *(LAS u32x2*)p_ = (u32x2){vreg[0].x, vreg[0].y}; *(LAS u32x2*)(p_ + 16) = (u32x2){vreg[0].z, vreg[0].w}; \
          p_ += 64 * MV_STRIDE; *(LAS u32x2*)p_ = (u32x2){vreg[1].x, vreg[1].y}; *(LAS u32x2*)(p_ + 16) = (u32x2){vreg[1].z, vreg[1].w}; } } while (0)
        MLA_LOAD(0); MLA_STORE(0);
        __syncthreads();
        for (int j = 0; j < NT; ++j) {
            const int buf = j & 1;
            if (j + 1 < NT) MLA_LOAD(j + 1);
            if (64 * j <= q0 + 31) {
                const LAS unsigned char* kb = lds + buf * MBUF; const LAS unsigned char* vb = kb + MK_BYTES;
                f32x16 st[2];
#pragma unroll
                for (int kvh = 0; kvh < 2; ++kvh)
#pragma unroll
                    for (int r = 0; r < 16; ++r) st[kvh][r] = 0.f;
                { const LAS unsigned char* kp0 = kb + r32 * MK_STRIDE + hi * 16; const LAS unsigned char* kp1 = kp0 + 32 * MK_STRIDE;
#define MLA_KF(i) (*(const LAS bf16x8*)((((i) & 1) ? kp1 : kp0) + ((i) >> 1) * 32))
                    bf16x8 kq[6];
#pragma unroll
                    for (int i = 0; i < 6; ++i) kq[i] = MLA_KF(i);
                    __builtin_amdgcn_sched_barrier(0);
#pragma unroll
                    for (int i = 0; i < 24; ++i) { st[i & 1] = __builtin_amdgcn_mfma_f32_32x32x16_bf16(kq[i % 6], qf[i >> 1], st[i & 1], 0, 0, 0);
                        if (i + 6 < 24) kq[i % 6] = MLA_KF(i + 6);
                        __builtin_amdgcn_sched_barrier(0); }
#undef MLA_KF
                }
                if (64 * j + 63 > q0) {
                    const int qg = q0 + r32;
#pragma unroll
                    for (int kvh = 0; kvh < 2; ++kvh)
#pragma unroll
                        for (int r = 0; r < 16; ++r) { const int kg = 64 * j + 32 * kvh + crow(r, hi); if (kg > qg) st[kvh][r] = -1e30f; }
                }
                const LAS unsigned char* vp0 = vb + r32 * MV_STRIDE + hi * 16;
#define MLA_VF(i) (*(const LAS bf16x8*)(vp0 + ((i) & 3) * (32 * MV_STRIDE) + ((i) >> 2) * 32))
                bf16x8 vq[4];
#pragma unroll
                for (int i = 0; i < 4; ++i) vq[i] = MLA_VF(i);
                float mx = st[0][0];
#pragma unroll
                for (int r = 1; r < 16; ++r) mx = fmaxf(mx, st[0][r]);
#pragma unroll
                for (int r = 0; r < 16; ++r) mx = fmaxf(mx, st[1][r]);
                mx = fmaxf(mx, __shfl_xor(mx, 32));
                const float mnew = (mx > mrun + 8.0f) ? mx : mrun;
                if (__any(mnew != mrun)) { const float alpha = __builtin_amdgcn_exp2f(mrun - mnew); lrun *= alpha;
#pragma unroll
                    for (int i = 0; i < 4; ++i)
#pragma unroll
                        for (int r = 0; r < 16; ++r) o[i][r] *= alpha;
                    mrun = mnew; }
                float ps = 0.f;
#pragma unroll
                for (int kvh = 0; kvh < 2; ++kvh)
#pragma unroll
                    for (int r = 0; r < 16; ++r) { const float p = __builtin_amdgcn_exp2f(st[kvh][r] - mrun); st[kvh][r] = p; ps += p; }
                lrun += ps;
                bf16x8 pf[4];
#pragma unroll
                for (int ks = 0; ks < 4; ++ks) { const int kvh = ks >> 1, rb = 8 * (ks & 1); u32x4 w;
                    w.x = cvt_pk_bf16(st[kvh][rb + 0], st[kvh][rb + 1]); w.y = cvt_pk_bf16(st[kvh][rb + 2], st[kvh][rb + 3]); w.z = cvt_pk_bf16(st[kvh][rb + 4], st[kvh][rb + 5]); w.w = cvt_pk_bf16(st[kvh][rb + 6], st[kvh][rb + 7]);
                    pf[ks] = __builtin_bit_cast(bf16x8, w); }
                __builtin_amdgcn_sched_barrier(0);
#pragma unroll
                for (int i = 0; i < 16; ++i) { o[i & 3] = __builtin_amdgcn_mfma_f32_32x32x16_bf16(vq[i % 4], pf[i >> 2], o[i & 3], 0, 0, 0);
                    if (i + 4 < 16) vq[i % 4] = MLA_VF(i + 4);
                    __builtin_amdgcn_sched_barrier(0); }
#undef MLA_VF
            }
            if (j + 1 < NT) MLA_STORE(buf ^ 1);
            __syncthreads();
        }
        lrun += __shfl_xor(lrun, 32);
        const float inv = 1.0f / lrun;
        bf16_t* op = O + (rowbase + q0 + r32) * 2048 + h * 128 + 4 * hi;
#pragma unroll
        for (int dvb = 0; dvb < 4; ++dvb)
#pragma unroll
            for (int g4 = 0; g4 < 4; ++g4) { u32x2 w; w.x = cvt_pk_bf16(o[dvb][4 * g4] * inv, o[dvb][4 * g4 + 1] * inv); w.y = cvt_pk_bf16(o[dvb][4 * g4 + 2] * inv, o[dvb][4 * g4 + 3] * inv);
                *(u32x2*)(op + 32 * dvb + 8 * g4) = w; }
#undef MLA_LOAD
#undef MLA_STORE
    }
}

constexpr int SK_STRIDE = 144, SV_STRIDE = 520, SK_BYTES = 256 * SK_STRIDE, SV_BYTES = 64 * SV_STRIDE, SB_OFF = SK_BYTES + SV_BYTES;
__device__ __forceinline__ void swa_attn_phase(LAS unsigned char* lds, const bf16_t* Q, const bf16_t* Kg, const bf16_t* VT, bf16_t* O, const float* bt2, const float* sinks, int G, int bx, const int tid) {
    const int lane = tid & 63, wid = __builtin_amdgcn_readfirstlane(tid >> 6), r32 = lane & 31, hi = lane >> 5;
    LAS unsigned char* ks_ = lds; LAS unsigned char* vs_ = lds + SK_BYTES; LAS float* bs_ = (LAS float*)(lds + SB_OFF);
    for (int L = bx; L < 512; L += G) {
        const int hk = L & 3, blk = (L >> 2) & 63, b = L >> 8;
        const size_t rowbase = (size_t)b * SEQ; const int t0 = blk * 128 - 128;
#pragma unroll
        for (int i = 0; i < 4; ++i) { const int p = tid + 512 * i, key = p >> 3, pc = p & 7; u32x4 v = {0u, 0u, 0u, 0u};
            if (t0 + key >= 0) v = *(const u32x4*)(Kg + (rowbase + t0 + key) * 256 + hk * 64 + pc * 8);
            *(LAS u32x4*)(ks_ + key * SK_STRIDE + pc * 16) = v; }
#pragma unroll
        for (int i = 0; i < 4; ++i) { const int p = tid + 512 * i, dv = p >> 5, pc = p & 31; u32x4 v = {0u, 0u, 0u, 0u};
            if (t0 + pc * 8 >= 0) v = *(const u32x4*)(VT + ((size_t)((b * 4 + hk) * 64 + dv)) * 8192 + t0 + pc * 8);
            LAS unsigned char* p_ = vs_ + dv * SV_STRIDE + pc * 16; *(LAS u32x2*)p_ = (u32x2){v.x, v.y}; *(LAS u32x2*)(p_ + 8) = (u32x2){v.z, v.w}; }
        for (int i = tid; i < 1024; i += 512) bs_[i] = bt2[(hk * 8) * 128 + i];
        __syncthreads();
        for (int ci = 0; ci < 4; ++ci) {
            const int c = wid + 8 * ci, g = c >> 2, qs = c & 3, head = hk * 8 + g;
            const size_t qrow = rowbase + blk * 128 + 32 * qs + r32;
            bf16x8 qf[4];
#pragma unroll
            for (int d0 = 0; d0 < 4; ++d0) qf[d0] = *(const bf16x8*)(Q + qrow * 2048 + head * 64 + d0 * 16 + hi * 8);
            const float sink2 = sinks[head] * LOG2E;
            float mrun = sink2, lrun = (hi == 0) ? 1.0f : 0.0f;
            f32x16 o[2];
#pragma unroll
            for (int i = 0; i < 2; ++i)
#pragma unroll
                for (int r = 0; r < 16; ++r) o[i][r] = 0.f;
#pragma unroll 1
            for (int kb = 0; kb < 5; ++kb) {
                f32x16 st;
#pragma unroll
                for (int r = 0; r < 16; ++r) st[r] = 0.f;
                const LAS unsigned char* kp_ = ks_ + (32 * (qs + kb) + r32) * SK_STRIDE + hi * 16;
#pragma unroll
                for (int d0 = 0; d0 < 4; ++d0) { const bf16x8 kf = *(const LAS bf16x8*)(kp_ + d0 * 32); st = __builtin_amdgcn_mfma_f32_32x32x16_bf16(kf, qf[d0], st, 0, 0, 0); }
                float mx = -1e30f;
#pragma unroll
                for (int r = 0; r < 16; ++r) { const int kl = 32 * kb + crow(r, hi);
                    const int dist = r32 + 128 - kl; const bool ok = (dist >= 0) && (dist < 128) && (t0 + 32 * qs + kl >= 0);
                    const float bv = bs_[g * 128 + (dist & 127)];
                    const float sv = ok ? st[r] + bv : -1e30f; st[r] = sv; mx = fmaxf(mx, sv); }
                mx = fmaxf(mx, __shfl_xor(mx, 32));
                const float mnew = fmaxf(mrun, mx), alpha = __builtin_amdgcn_exp2f(mrun - mnew); mrun = mnew;
                float ps = 0.f;
#pragma unroll
                for (int r = 0; r < 16; ++r) { const float p = __builtin_amdgcn_exp2f(st[r] - mnew); st[r] = p; ps += p; }
                lrun = lrun * alpha + ps;
#pragma unroll
                for (int i = 0; i < 2; ++i)
#pragma unroll
                    for (int r = 0; r < 16; ++r) o[i][r] *= alpha;
#pragma unroll
                for (int k2 = 0; k2 < 2; ++k2) { const int rb = 8 * k2; u32x4 w;
                    w.x = cvt_pk_bf16(st[rb + 0], st[rb + 1]); w.y = cvt_pk_bf16(st[rb + 2], st[rb + 3]); w.z = cvt_pk_bf16(st[rb + 4], st[rb + 5]); w.w = cvt_pk_bf16(st[rb + 6], st[rb + 7]);
                    const bf16x8 pf = __builtin_bit_cast(bf16x8, w);
#pragma unroll
                    for (int dvb = 0; dvb < 2; ++dvb) { const LAS unsigned char* vp = vs_ + (32 * dvb + r32) * SV_STRIDE + (32 * (qs + kb) + 16 * k2 + 4 * hi) * 2;
                        const u32x2 lo = *(const LAS u32x2*)vp, hi2 = *(const LAS u32x2*)(vp + 16); const u32x4 vw = {lo.x, lo.y, hi2.x, hi2.y};
                        o[dvb] = __builtin_amdgcn_mfma_f32_32x32x16_bf16(__builtin_bit_cast(bf16x8, vw), pf, o[dvb], 0, 0, 0); } }
            }
            lrun += __shfl_xor(lrun, 32);
            const float inv = 1.0f / lrun;
            bf16_t* op = O + qrow * 2048 + head * 64 + 4 * hi;
#pragma unroll
            for (int dvb = 0; dvb < 2; ++dvb)
#pragma unroll
                for (int g4 = 0; g4 < 4; ++g4) { u32x2 w; w.x = cvt_pk_bf16(o[dvb][4 * g4] * inv, o[dvb][4 * g4 + 1] * inv); w.y = cvt_pk_bf16(o[dvb][4 * g4 + 2] * inv, o[dvb][4 * g4 + 3] * inv);
                    *(u32x2*)(op + 32 * dvb + 8 * g4) = w; }
        }
        __syncthreads();
    }
}

__device__ __forceinline__ void rwkv_mix_phase(const float* y, const float* stats, const float* lg, const float* lb, const float* mix, bf16_t* X6, int gt, int NGT) {
    for (int idx = gt; idx < M * 256; idx += NGT) { const int row = idx >> 8, c = (idx & 255) * 8; const size_t off = (size_t)row * 2048 + c;
        const f32x4 g0 = *(const f32x4*)(lg + c), g1 = *(const f32x4*)(lg + c + 4), b0 = *(const f32x4*)(lb + c), b1 = *(const f32x4*)(lb + c + 4);
        const f32x2 ms = *(const f32x2*)(stats + 2 * (size_t)row);
        const f32x4 x0 = (*(const f32x4*)(y + off) - ms[0]) * ms[1] * g0 + b0, x1 = (*(const f32x4*)(y + off + 4) - ms[0]) * ms[1] * g1 + b1; f32x4 p0 = {0.f, 0.f, 0.f, 0.f}, p1 = p0;
        if ((row & 8191) != 0) { const f32x2 mp = *(const f32x2*)(stats + 2 * (size_t)row - 2); p0 = (*(const f32x4*)(y + off - 2048) - mp[0]) * mp[1] * g0 + b0; p1 = (*(const f32x4*)(y + off - 2044) - mp[0]) * mp[1] * g1 + b1; }
        const f32x4 d0 = p0 - x0, d1 = p1 - x1;
#pragma unroll
        for (int s = 0; s < 6; ++s) { const int mr = (s == 0) ? 0 : (s == 1) ? 2 : (s == 2) ? 3 : (s == 3) ? 1 : s;
            const f32x4 m0 = *(const f32x4*)(mix + mr * 2048 + c), m1 = *(const f32x4*)(mix + mr * 2048 + c + 4);
            *(u32x4*)(X6 + (size_t)s * (SLOT / 2) + off) = pack8(x0 + d0 * m0, x1 + d1 * m1); }
    }
}
constexpr int SC_T = 32, SC_TOK = 1536, SC_BUF = SC_T * SC_TOK;
__device__ __forceinline__ void rwkv_scan_phase(LAS unsigned char* lds, const bf16_t* RKV, const float* DEC, const float* AF, const float* k_k, const float* k_a, const float* r_k, float* BON, float* Y, int bx, const int tid) {
    const int lane = tid & 63, wid = __builtin_amdgcn_readfirstlane(tid >> 6);
    const int bh = bx >> 2, rq = bx & 3, b = bh >> 5, h = bh & 31; const size_t rowbase = (size_t)b * SEQ;
    const int ptid = tid - 256, ptok = ptid >> 4, pc4 = (ptid & 15) * 4;
    f32x4 kk4 = {0.f, 0.f, 0.f, 0.f}, ka4 = kk4, rk4 = kk4;
    if (wid >= 4) { kk4 = *(const f32x4*)(k_k + h * 64 + pc4); ka4 = *(const f32x4*)(k_a + h * 64 + pc4); rk4 = *(const f32x4*)(r_k + h * 64 + pc4); }
    u32x2 prw[2], pkw[2], pvw[2]; f32x4 pw4[2], pa4[2];
#pragma unroll
    for (int i = 0; i < 2; ++i) { prw[i] = (u32x2){0u, 0u}; pkw[i] = prw[i]; pvw[i] = prw[i]; pw4[i] = (f32x4){0.f, 0.f, 0.f, 0.f}; pa4[i] = pw4[i]; }
#define SCAN_LOAD(c) do { _Pragma("unroll") for (int ps_ = 0; ps_ < 2; ++ps_) { const int tl = ptok + 16 * ps_; const size_t off = (rowbase + (size_t)(c) * SC_T + tl) * 2048 + h * 64 + pc4; \
        prw[ps_] = *(const u32x2*)(RKV + off); pkw[ps_] = *(const u32x2*)(RKV + (SLOT / 2) + off); pvw[ps_] = *(const u32x2*)(RKV + 2 * (SLOT / 2) + off); \
        pw4[ps_] = *(const f32x4*)(DEC + off); pa4[ps_] = *(const f32x4*)(AF + off); } } while (0)
#define SCAN_STORE(buf, c) do { _Pragma("unroll") for (int ps_ = 0; ps_ < 2; ++ps_) { const int tl = ptok + 16 * ps_; const u32x2 rw = prw[ps_], kw = pkw[ps_], vw = pvw[ps_]; const f32x4 w4 = pw4[ps_], a4 = pa4[ps_]; \
        const f32x4 r4 = {bflo(rw.x), bfhi(rw.x), bflo(rw.y), bfhi(rw.y)}, k4 = {bflo(kw.x), bfhi(kw.x), bflo(kw.y), bfhi(kw.y)}, v4 = {bflo(vw.x), bfhi(vw.x), bflo(vw.y), bfhi(vw.y)}; \
        const f32x4 kr = k4 * kk4; float ss = (kr[0] * kr[0] + kr[1] * kr[1]) + (kr[2] * kr[2] + kr[3] * kr[3]); ss = sum16(ss); \
        const float rn = 1.0f / fmaxf(sqrtf(ss), 1e-12f); const f32x4 kn = kr * rn; const f32x4 kp = k4 * (1.0f + (a4 - 1.0f) * ka4); \
        { const f32x4 tb = r4 * kp * rk4; const float bon = sum16((tb[0] + tb[1]) + (tb[2] + tb[3])); if (rq == 0 && pc4 == 0) BON[(rowbase + (size_t)(c) * SC_T + tl) * 32 + h] = bon; } \
        LAS unsigned char* d_ = lds + (buf) * SC_BUF + tl * SC_TOK + pc4 * 4; \
        *(LAS f32x4*)(d_) = r4; *(LAS f32x4*)(d_ + 256) = w4; *(LAS f32x4*)(d_ + 512) = kp; *(LAS f32x4*)(d_ + 768) = v4; *(LAS f32x4*)(d_ + 1024) = -kn; *(LAS f32x4*)(d_ + 1280) = kn * a4; } } while (0)
    const int ks4 = (lane & 15) * 16, rowi = 16 * rq + 4 * wid + (lane >> 4);
    f32x2 S01 = {0.f, 0.f}, S23 = {0.f, 0.f};
    float* yp = Y + rowbase * 2048 + h * 64 + rowi;
    if (wid >= 4) { SCAN_LOAD(0); SCAN_STORE(0, 0); SCAN_LOAD(1); }
    __syncthreads();
    for (int c = 0; c < SEQ / SC_T; ++c) {
        if (wid >= 4) { if (c + 1 < SEQ / SC_T) { SCAN_STORE((c + 1) & 1, c + 1); if (c + 2 < SEQ / SC_T) SCAN_LOAD(c + 2); } }
        else {
            const LAS unsigned char* base = lds + (c & 1) * SC_BUF + ks4; const LAS unsigned char* vbase = lds + (c & 1) * SC_BUF + 768 + rowi * 4;
            f32x4 r4 = *(const LAS f32x4*)(base), w4 = *(const LAS f32x4*)(base + 256), k4 = *(const LAS f32x4*)(base + 512), a4 = *(const LAS f32x4*)(base + 1024), b4 = *(const LAS f32x4*)(base + 1280);
            float vv = *(const LAS float*)(vbase); float ykeep = 0.f;
#pragma unroll
            for (int t = 0; t < SC_T; ++t) {
                f32x4 r4n = r4, w4n = w4, k4n = k4, a4n = a4, b4n = b4; float vvn = vv;
                if (t + 1 < SC_T) { const LAS unsigned char* p = base + (t + 1) * SC_TOK;
                    r4n = *(const LAS f32x4*)(p); w4n = *(const LAS f32x4*)(p + 256); k4n = *(const LAS f32x4*)(p + 512); a4n = *(const LAS f32x4*)(p + 1024); b4n = *(const LAS f32x4*)(p + 1280);
                    vvn = *(const LAS float*)(vbase + (t + 1) * SC_TOK); }
                const f32x2 a01 = {a4[0], a4[1]}, a23 = {a4[2], a4[3]}, w01 = {w4[0], w4[1]}, w23 = {w4[2], w4[3]}, b01 = {b4[0], b4[1]}, b23 = {b4[2], b4[3]}, k01 = {k4[0], k4[1]}, k23 = {k4[2], k4[3]}, r01 = {r4[0], r4[1]}, r23 = {r4[2], r4[3]};
                const f32x2 tsa = S01 * a01 + S23 * a23; const float sa = sum16(tsa[0] + tsa[1]);
                S01 = S01 * w01 + (b01 * sa + k01 * vv); S23 = S23 * w23 + (b23 * sa + k23 * vv);
                const f32x2 ty = S01 * r01 + S23 * r23; const float y = sum16(ty[0] + ty[1]);
                ykeep = ((lane & 15) == (t & 15)) ? y : ykeep;
                if ((t & 15) == 15) yp[(size_t)(c * SC_T + (t - 15) + (lane & 15)) * 2048] = ykeep;
                r4 = r4n; w4 = w4n; k4 = k4n; a4 = a4n; b4 = b4n; vv = vvn;
            }
        }
        __syncthreads();
    }
#undef SCAN_LOAD
#undef SCAN_STORE
}
__device__ __forceinline__ void rwkv_gn_phase(const float* Y, const bf16_t* Vb, const float* BON, const bf16_t* GB, const float* ln_g, const float* ln_b, bf16_t* YG, int gw, int NGW, int lane) {
    const int c4 = (lane & 15) * 4, sub = lane >> 4;
    for (int it = gw * 4 + sub; it < M * 32; it += NGW * 4) { const int row = it >> 5, h = it & 31; const int ch = h * 64 + c4; const size_t off = (size_t)row * 2048 + ch;
        const f32x4 y4 = *(const f32x4*)(Y + off);
        const u32x2 vw = *(const u32x2*)(Vb + off), gw2 = *(const u32x2*)(GB + off); const float bonus = BON[it];
        const f32x4 lg = *(const f32x4*)(ln_g + ch), lb = *(const f32x4*)(ln_b + ch);
        const float mean = sum16((y4[0] + y4[1]) + (y4[2] + y4[3])) * (1.f / 64.f); const f32x4 d = y4 - mean;
        const float var = sum16((d[0] * d[0] + d[1] * d[1]) + (d[2] * d[2] + d[3] * d[3])) * (1.f / 64.f); const float rstd = 1.0f / sqrtf(var + 64e-5f);
        const f32x4 v4 = {bflo(vw.x), bfhi(vw.x), bflo(vw.y), bfhi(vw.y)}, g4 = {bflo(gw2.x), bfhi(gw2.x), bflo(gw2.y), bfhi(gw2.y)};
        const f32x4 outv = (d * rstd * lg + lb + v4 * bonus) * g4;
        u32x2 w; w.x = cvt_pk_bf16(outv[0], outv[1]); w.y = cvt_pk_bf16(outv[2], outv[3]); *(u32x2*)(YG + off) = w; }
}

#define XB_TMO      128
#define XB_XCNT(j)  (256  + 64 * (j))
#define XB_XSUB(j)  (1280 + 64 * (j))
#define XB_XGEN(j)  (2304 + 64 * (j))
#define XB_TOP      3328
#define XB_TOPGEN   3392
#define XCD_BAR_WORDS 3456
#define XB_SPIN_CAP (1u << 18)
__device__ __forceinline__ unsigned xb_ld(unsigned* p)              { return __hip_atomic_load(p, __ATOMIC_RELAXED, __HIP_MEMORY_SCOPE_AGENT); }
__device__ __forceinline__ unsigned xb_add(unsigned* p, unsigned v) { return __hip_atomic_fetch_add(p, v, __ATOMIC_RELAXED, __HIP_MEMORY_SCOPE_AGENT); }
__device__ __forceinline__ unsigned xb_xcc_id() { return (unsigned)__builtin_amdgcn_s_getreg((3 << 11) | 20) & 0xFu; }
#define XB_SPIN(cond, bar) do { unsigned _sp = 0; while (cond) { __builtin_amdgcn_s_sleep(1); \
    if ((++_sp & 255u) == 0u) { if (xb_ld(&(bar)[XB_TMO])) break; if (_sp > XB_SPIN_CAP) { atomicAdd(&(bar)[XB_TMO], 1u); break; } } } } while (0)
struct XcdBarrier { unsigned* bar; unsigned x; volatile LAS unsigned* st; };
__device__ __forceinline__ XcdBarrier xcd_barrier_post(unsigned* bar, volatile LAS unsigned* st) {
    XcdBarrier b; b.bar = bar; b.x = xb_xcc_id(); b.st = st;
    if (threadIdx.x == 0) (void)xb_add(&bar[XB_XCNT(b.x)], 1u);
    return b;
}
__device__ __forceinline__ void xcd_barrier_complete(unsigned* bar, unsigned x, unsigned& nloc, unsigned& nx) {
    const unsigned G = gridDim.x * gridDim.y * gridDim.z;
    unsigned sum, cnt, mine, sp = 0u;
    for (;;) {
        sum = 0u; cnt = 0u; mine = 0u;
#pragma unroll
        for (unsigned j = 0; j < 16; ++j) { const unsigned c = xb_ld(&bar[XB_XCNT(j)]); sum += c; cnt += (c > 0u) ? 1u : 0u; mine = (j == x) ? c : mine; }
        if (sum == G) break;
        __builtin_amdgcn_s_sleep(1);
        if ((++sp & 255u) == 0u) { if (xb_ld(&bar[XB_TMO])) break; if (sp > XB_SPIN_CAP) { atomicAdd(&bar[XB_TMO], 1u); break; } }
    }
    nloc = mine > 0u ? mine : 1u; nx = cnt > 0u ? cnt : 1u;
}
__device__ __forceinline__ void xcd_barrier(const XcdBarrier& b) {
    asm volatile("s_waitcnt vmcnt(0)" ::: "memory");
    __syncthreads();
    if (threadIdx.x == 0) {
        unsigned* bar = b.bar;
        __builtin_amdgcn_s_waitcnt(0);
        unsigned nloc = b.st[0], nx = b.st[1];
        if (nloc == 0u) { xcd_barrier_complete(bar, b.x, nloc, nx); b.st[0] = nloc; b.st[1] = nx; }
        const unsigned old = xb_add(&bar[XB_XSUB(b.x)], 1u);
        const unsigned gen = old / nloc;
        if (old + 1u == (gen + 1u) * nloc) {
            __builtin_amdgcn_fence(__ATOMIC_RELEASE, "agent");
            asm volatile("s_waitcnt vmcnt(0)" ::: "memory");
            const unsigned og = xb_add(&bar[XB_TOP], 1u);
            const unsigned tg = og / nx;
            if (og + 1u == (tg + 1u) * nx) xb_add(&bar[XB_TOPGEN], 1u);
            else XB_SPIN(xb_ld(&bar[XB_TOPGEN]) == tg, bar);
            __builtin_amdgcn_fence(__ATOMIC_ACQUIRE, "agent");
            xb_add(&bar[XB_XGEN(b.x)], 1u);
            asm volatile("s_waitcnt vmcnt(0)" ::: "memory");
        } else {
            XB_SPIN(xb_ld(&bar[XB_XGEN(b.x)]) == gen, bar);
            __builtin_amdgcn_fence(__ATOMIC_ACQUIRE, "agent");
            asm volatile("s_waitcnt vmcnt(0)" ::: "memory");
        }
    }
    __syncthreads();
}

struct Args { const float* in[33]; float* out; unsigned char* ws; int ph_lo, ph_hi; };
#ifndef PROBE_N
#define PROBE_N 0
#define PROBE_MAP(i) 0
#endif
constexpr int N_PHASES = 36 + PROBE_N;
typedef const __attribute__((address_space(4))) unsigned char* kargp_t;
#define IN(i) (*(const float* const __attribute__((address_space(4)))*)(kp + 8 * (i)))
__global__ void __launch_bounds__(512, 2) hybrid_fwd(Args args) {
    extern __shared__ __attribute__((aligned(16))) unsigned char lds_raw[];
    LAS unsigned char* lds = (LAS unsigned char*)lds_raw;
    cg::grid_group grid = cg::this_grid();
    const kargp_t karg = (kargp_t)__builtin_amdgcn_kernarg_segment_ptr();
    const int ph_lo = args.ph_lo, ph_hi = args.ph_hi;
    volatile LAS unsigned* MISC = (volatile LAS unsigned*)(lds + LDS_BYTES - 256);
    if (threadIdx.x < 64) MISC[threadIdx.x] = 0u;
    __syncthreads();
    const XcdBarrier xb = xcd_barrier_post((unsigned*)(args.ws + WS_BAR), MISC + 8);

    for (int phx = ph_lo; phx < ph_hi; ++phx) {
        const int ph = (phx < 36) ? phx : (PROBE_MAP(phx - 36));
        int tid = threadIdx.x; asm volatile("" : "+v"(tid));
        const int lane = tid & 63, wave = __builtin_amdgcn_readfirstlane(tid >> 6);
        int G = gridDim.x, bx = blockIdx.x; asm volatile("" : "+s"(G), "+s"(bx));
        const int gw = bx * 8 + wave, NGW = G * 8, gt = bx * 512 + tid, NGT = G * 512;
        LAS float* scr = (LAS float*)(lds + wave * 16640);
        kargp_t kp = karg; asm volatile("" : "+s"(kp));
        float* hout = *(float* const __attribute__((address_space(4)))*)(kp + 8 * 33); unsigned char* ws = *(unsigned char* const __attribute__((address_space(4)))*)(kp + 8 * 34);
        unsigned char* ar = ws + WS_AR; const float* x_in = IN(0);
        bf16_t* HB = (bf16_t*)(ws + WS_HB); float* Yb = (float*)(ws + WS_Y);
        float* tab = (float*)(ws + WS_TAB); float* bt2 = (float*)(ws + WS_BT); float* stats = (float*)(ws + WS_STATS);
        int layer, kind, sub;
        if (ph == 0 || ph >= 100) { layer = -1; kind = -1; sub = 0; }
        else if (ph < 10) { layer = 0; kind = 0; sub = ph - 1; }
        else if (ph < 20) { layer = 1; kind = 1; sub = ph - 10; }
        else if (ph < 27) { layer = 2; kind = 2; sub = ph - 20; }
        else { layer = 3; kind = 0; sub = ph - 27; }
        const int nsub = (kind == 0) ? 9 : (kind == 1) ? 10 : 7;
        const int tail = sub - (nsub - 4);
        const bool nosync = (kind == 0 && sub == 2) || (kind == 1 && sub == 1);
        if (phx > ph_lo && !nosync) { if (ph_hi < 0) grid.sync(); else xcd_barrier(xb); }
        const float* hres = (layer <= 0) ? x_in : Yb;
        const float* rg = (layer <= 0) ? nullptr : IN(29) + (size_t)((layer - 1) * 2 + 1) * 2048; const float* rb = (layer <= 0) ? nullptr : IN(30) + (size_t)((layer - 1) * 2 + 1) * 2048;
        pg8::Gemm g0{}; EpiP e0{}; int ng = 0;

        if (ph >= 100) {
        } else if (ph == 0) {
            for (int job = 0; job < 18; ++job) {
                const float* W = nullptr; int Ks = 0, Ns = 0, ldwt = 0, Nd = 0, kd = 0; const float* rs = nullptr; bf16_t* WT = nullptr;
                if (job < 8) { const int j = job >> 2, w = job & 3; unsigned char* base = ws + WS_MLA_W + (size_t)j * 20 * MiB;
                    if (w == 0) { W = IN(1) + (size_t)j * 2048 * 1088; Ks = 2048; Ns = 1088; WT = (bf16_t*)base; ldwt = 2048; Nd = 1280; kd = 1; }
                    else if (w == 1) { W = IN(4) + (size_t)j * 512 * 3072; Ks = 512; Ns = 3072; WT = (bf16_t*)(base + 5 * MiB); ldwt = 512; Nd = 3072; kd = 2; rs = IN(2) + j * 512; }
                    else if (w == 2) { W = IN(5) + (size_t)j * 512 * 4096; Ks = 512; Ns = 4096; WT = (bf16_t*)(base + 8 * MiB); ldwt = 512; Nd = 4096; kd = 0; rs = IN(3) + j * 512; }
                    else { W = IN(6) + (size_t)j * 2048 * 2048; Ks = 2048; Ns = 2048; WT = (bf16_t*)(base + 12 * MiB); ldwt = 2048; Nd = 2048; kd = 0; } }
                else if (job < 11) { const int n = job - 8; W = IN(8) + (size_t)n * 2048 * 2048; Ks = 2048; Ns = 2048; WT = (bf16_t*)(ws + WS_RW_W) + (size_t)n * 2048 * 2048; ldwt = 2048; Nd = 2048; }
                else if (job == 11) { W = IN(10); Ks = 2048; Ns = 96; WT = (bf16_t*)(ws + WS_RW_W + 24 * MiB); ldwt = 2048; Nd = 256; }
                else if (job == 12) { W = IN(13); Ks = 2048; Ns = 96; WT = (bf16_t*)(ws + WS_RW_W + 24 * MiB) + (size_t)256 * 2048; ldwt = 2048; Nd = 256; }
                else if (job == 13) { W = IN(15); Ks = 2048; Ns = 256; WT = (bf16_t*)(ws + WS_RW_W + 24 * MiB) + (size_t)512 * 2048; ldwt = 2048; Nd = 256; }
                else if (job == 14) { W = IN(16); Ks = 256; Ns = 2048; WT = (bf16_t*)(ws + WS_RW_W + 27 * MiB) + (size_t)4096 * 256; ldwt = 256; Nd = 2048; }
                else if (job == 15) { W = IN(22); Ks = 2048; Ns = 2048; WT = (bf16_t*)(ws + WS_RW_W + 30 * MiB); ldwt = 2048; Nd = 2048; }
                else if (job == 16) { W = IN(23); Ks = 2048; Ns = 2560; WT = (bf16_t*)(ws + WS_SW_W); ldwt = 2048; Nd = 2560; }
                else { W = IN(26); Ks = 2048; Ns = 2048; WT = (bf16_t*)(ws + WS_SW_W + 10 * MiB); ldwt = 2048; Nd = 2048; }
                transpose_w(W, Ks, Ns, WT, ldwt, Nd, kd, rs, scr, (gw + job * 227) % NGW, NGW, lane);
            }
            transpose_small(IN(11), (bf16_t*)(ws + WS_RW_W + 27 * MiB), gt, NGT);
            transpose_small(IN(14), (bf16_t*)(ws + WS_RW_W + 27 * MiB) + (size_t)2048 * 256, gt, NGT);
            for (int idx = gt; idx < 8192 * 32; idx += NGT) { const int pos = idx >> 5, i = idx & 31;
                float c, s; rope_cs(pos, i, c, s);
                tab[2 * idx] = c; tab[2 * idx + 1] = s; }
            { const float* rb = IN(28);
            for (int idx = gt; idx < 32 * 128; idx += NGT) { const int hd = idx >> 7, n = idx & 127; int bucket;
                if (n < 16) bucket = n; else { const float nf = (float)n; int lg = 16 + (int)(logf(nf / 16.0f) / 2.0794415416798357f * 16.0f); lg = lg < 31 ? lg : 31; bucket = lg; }
                bt2[idx] = rb[bucket * 32 + hd] * LOG2E; } }
            for (int idx = gt; idx < M * 256; idx += NGT) { const size_t off = (size_t)idx * 8; *(u32x4*)(HB + off) = pack8(*(const f32x4*)(x_in + off), *(const f32x4*)(x_in + off + 4)); }
        } else if (tail == 0 || tail == 3) {
            const float* lg = IN(29) + (size_t)(layer * 2 + (tail == 3 ? 1 : 0)) * 2048; const float* lb = IN(30) + (size_t)(layer * 2 + (tail == 3 ? 1 : 0)) * 2048;
            if (tail == 0) {
                transpose_w(IN(31) + (size_t)layer * 2048 * 8192, 2048, 8192, (bf16_t*)(ws + WS_MLPW), 2048, 8192, 0, nullptr, scr, gw, NGW, lane);
                transpose_w(IN(32) + (size_t)layer * 8192 * 2048, 8192, 2048, (bf16_t*)(ws + WS_MLPW + 32 * MiB), 8192, 2048, 0, nullptr, scr, gw, NGW, lane);
            }
            if (layer == 0 && tail == 3) {
                for (int row = gw * 4; row < M; row += NGW * 4) ln_mix_rows4(Yb + (size_t)row * 2048, row, lg, lb, IN(7), (bf16_t*)(ar + AR_X6), stats + 2 * (size_t)row, lane);
            } else {
                for (int row = gw * 4; row < M; row += NGW * 4) ln_rows4(Yb + (size_t)row * 2048, lg, lb, hout + (size_t)row * 2048, HB + (size_t)row * 2048, stats + 2 * (size_t)row, layer == 3 && tail == 3, lane);
            }
        } else if (tail == 1) {
            g0 = pg8::Gemm{HB, (const bf16_t*)(ws + WS_MLPW), M, FF, 2048, 2048, 2048, 1 << 20, 0}; e0.mode = EM_RELU2; e0.o0 = (bf16_t*)(ar + AR_HID); e0.ldc = FF; ng = 1;
        } else if (tail == 2) {
            g0 = pg8::Gemm{(const bf16_t*)(ar + AR_HID), (const bf16_t*)(ws + WS_MLPW + 32 * MiB), M, 2048, FF, FF, FF, 1 << 20, 0}; e0.mode = EM_RESID; e0.res = Yb; e0.outf = Yb; e0.f0 = stats; e0.p0 = IN(29) + (size_t)(layer * 2) * 2048; e0.p1 = IN(30) + (size_t)(layer * 2) * 2048; e0.ldc = 2048; ng = 1;
        } else if (kind == 0) {
            const int j = layer == 0 ? 0 : 1; unsigned char* wb = ws + WS_MLA_W + (size_t)j * 20 * MiB;
            bf16_t* LAT = (bf16_t*)(ar + AR_LAT); float* PART = (float*)(ar + AR_PART); bf16_t* KROPE = (bf16_t*)(ar + AR_KROPE); bf16_t* Qb = (bf16_t*)(ar + AR_Q);
            bf16_t* KN = (bf16_t*)(ar + AR_KN); bf16_t* VT = (bf16_t*)(ar + AR_VT); bf16_t* Ob = (bf16_t*)(ar + AR_O);
            if (sub == 0) { g0 = pg8::Gemm{HB, (const bf16_t*)wb, M, 1280, 2048, 2048, 2048, 1 << 20, 0}; e0.mode = EM_MLA_IN; e0.o0 = LAT; e0.f0 = PART; e0.o1 = KROPE; e0.tab = tab; ng = 1; }
            else if (sub == 1) { g0 = pg8::Gemm{LAT, (const bf16_t*)(wb + 5 * MiB), M, 3072, 512, 1024, 512, 1 << 20, 0}; e0.mode = EM_MLA_Q; e0.o0 = Qb; e0.f0 = PART; e0.tab = tab; ng = 1; }
            else if (sub == 2) { g0 = pg8::Gemm{LAT + 512, (const bf16_t*)(wb + 8 * MiB), M, 4096, 512, 1024, 512, 1 << 20, 0}; e0.mode = EM_MLA_KV; e0.o0 = KN; e0.o1 = VT; e0.f0 = PART; ng = 1; }
            else if (sub == 3) {
#ifndef NO_MLA
                mla_attn_phase(lds, Qb, KN, KROPE, VT, Ob, G, bx, tid);
#endif
            }
            else { g0 = pg8::Gemm{Ob, (const bf16_t*)(wb + 12 * MiB), M, 2048, 2048, 2048, 2048, 1 << 20, 0}; e0.mode = EM_RESID; e0.res = hres; e0.outf = Yb; e0.f0 = stats; e0.p0 = rg; e0.p1 = rb; e0.ldc = 2048; ng = 1; }
        } else if (kind == 1) {
            bf16_t* X6 = (bf16_t*)(ar + AR_X6); bf16_t* RKV = (bf16_t*)(ar + AR_RKV); bf16_t* LH = (bf16_t*)(ar + AR_LH);
            float* DEC = (float*)(ar + AR_DEC); float* AF = (float*)(ar + AR_AF); bf16_t* GB = (bf16_t*)(ar + AR_GB); bf16_t* YG = (bf16_t*)(ar + AR_YG);
            unsigned char* wb = ws + WS_RW_W;
            if (sub == 0) { g0 = pg8::Gemm{X6, (const bf16_t*)wb, M, 6144, 2048, 2048, 2048, 8, SLOT}; e0.mode = EM_SPLIT; e0.o0 = RKV; ng = 1; }
            else if (sub == 1) { g0 = pg8::Gemm{X6 + 3 * (SLOT / 2), (const bf16_t*)(wb + 24 * MiB), M, 768, 2048, 2048, 2048, 1, SLOT}; e0.mode = EM_LORA_DOWN; e0.o0 = LH; ng = 1; }
            else if (sub == 2) { g0 = pg8::Gemm{LH, (const bf16_t*)(wb + 27 * MiB), M, 6144, 256, 768, 256, 8, 512}; e0.mode = EM_LORA_UP; e0.f0 = DEC; e0.f1 = AF; e0.o0 = GB; e0.p0 = IN(9); e0.p1 = IN(12); ng = 1; }
            else if (sub == 3) {
#ifndef NO_SCAN
                if (G == 256) rwkv_scan_phase(lds, RKV, DEC, AF, IN(17), IN(18), IN(19), (float*)(ar + AR_BON), hout, bx, tid);
#endif
            }
            else if (sub == 4) { rwkv_gn_phase(hout, RKV + 2 * (SLOT / 2), (const float*)(ar + AR_BON), GB, IN(20), IN(21), YG, gw, NGW, lane); }
            else { g0 = pg8::Gemm{YG, (const bf16_t*)(wb + 30 * MiB), M, 2048, 2048, 2048, 2048, 1 << 20, 0}; e0.mode = EM_RESID; e0.res = hres; e0.outf = Yb; e0.f0 = stats; e0.p0 = rg; e0.p1 = rb; e0.ldc = 2048; ng = 1; }
        } else {
            bf16_t* SQ = (bf16_t*)(ar + AR_SQ); bf16_t* SK = (bf16_t*)(ar + AR_SK); bf16_t* SVT = (bf16_t*)(ar + AR_SVT); bf16_t* SO = (bf16_t*)(ar + AR_SO);
            unsigned char* wb = ws + WS_SW_W;
            if (sub == 0) { g0 = pg8::Gemm{HB, (const bf16_t*)wb, M, 2560, 2048, 2048, 2048, 1 << 20, 0}; e0.mode = EM_SWA_QKV; e0.o0 = SQ; e0.o1 = SK; e0.o2 = SVT; e0.bias = IN(24); ng = 1; }
            else if (sub == 1) {
#ifndef NO_SWA
                swa_attn_phase(lds, SQ, SK, SVT, SO, bt2, IN(25), G, bx, tid);
#endif
            }
            else { g0 = pg8::Gemm{SO, (const bf16_t*)(wb + 10 * MiB), M, 2048, 2048, 2048, 2048, 1 << 20, 0}; e0.mode = EM_RESID; e0.res = hres; e0.outf = Yb; e0.f0 = stats; e0.p0 = rg; e0.p1 = rb; e0.bias = IN(27); e0.ldc = 2048; ng = 1; }
        }
#ifndef NO_GEMM
        if (ng) { pg8::StaticOrder S; S.init(g0.M, g0.N, G, bx); pg8::gemm_phase<EpiP>(lds, g0, S, e0, tid); }
#endif
    }
}

extern "C" void kernel_launch(void* const* d_in, const int* in_sizes, int n_in, void* d_out, int out_size, void* d_ws, size_t ws_size, hipStream_t stream) {
    static int grid = 0;
    if (grid == 0) {
        if (n_in != 33 || out_size != M * DM || ws_size < WS_END) { fprintf(stderr, "kernel_launch: unexpected problem (n_in %d, out %d, ws %zu < %zu)\n", n_in, out_size, ws_size, (size_t)WS_END); grid = -1; return; }
        int dev = 0, cus = 0, per_cu = 0;
        hipGetDevice(&dev); hipDeviceGetAttribute(&cus, hipDeviceAttributeMultiprocessorCount, dev);
        if (hipFuncSetAttribute((const void*)hybrid_fwd, hipFuncAttributeMaxDynamicSharedMemorySize, LDS_BYTES) != hipSuccess) { fprintf(stderr, "kernel_launch: hipFuncSetAttribute failed\n"); grid = -1; return; }
        if (hipOccupancyMaxActiveBlocksPerMultiprocessor(&per_cu, (const void*)hybrid_fwd, 512, LDS_BYTES) != hipSuccess || per_cu < 1) { fprintf(stderr, "kernel_launch: occupancy query says %d\n", per_cu); per_cu = 1; }
        (void)hipGetLastError();
        grid = cus;
        fprintf(stderr, "kernel_launch: grid %d (cus %d, per_cu %d)\n", grid, cus, per_cu);
    }
    if (grid < 0) return;
    Args a{};
    for (int i = 0; i < 33; ++i) a.in[i] = (const float*)d_in[i];
    a.out = (float*)d_out; a.ws = (unsigned char*)d_ws;
#ifndef MK_PER_PHASE
    a.ph_lo = 0; a.ph_hi = N_PHASES;
    if (hipMemsetAsync((char*)d_ws + WS_BAR, 0, WS_BAR_BYTES, stream) != hipSuccess) { fprintf(stderr, "kernel_launch: memset of the barrier words failed\n"); return; }
    void* kargs[] = {&a};
    hipError_t e = hipLaunchCooperativeKernel((const void*)hybrid_fwd, dim3(grid), dim3(512), kargs, LDS_BYTES, stream);
    if (e != hipSuccess) fprintf(stderr, "cooperative launch failed: %s (grid %d)\n", hipGetErrorString(e), grid);
#else
    for (int ph = 0; ph < N_PHASES; ++ph) { a.ph_lo = ph; a.ph_hi = ph + 1; hipLaunchKernelGGL(hybrid_fwd, dim3(grid), dim3(512), LDS_BYTES, stream, a); }
#endif
}
```
